# Optimizing an MI355X kernel written in HIP

```python
import jax, jax.numpy as jnp
from jax import lax
import numpy as np

D_MODEL = 1024
BATCH = 4
SEQ = 4096
DEPTH = 2

CHUNK = 64
N_MIXERS = 2
N_RWKV = (DEPTH + 1) // 2
N_MLSTM = DEPTH // 2
EPS = 1e-6
NEG = -1e30

RW_HEAD = 64
RW_HEADS = D_MODEL // RW_HEAD
LORA_W = 64
LORA_A = 64
LORA_G = 160
RW_SEGS = (D_MODEL, LORA_W, D_MODEL, D_MODEL, LORA_A, LORA_G)
RW_IN = sum(RW_SEGS)
GN_EPS = 64e-5

ML_HEADS = 8
ML_QK = D_MODEL // 2 // ML_HEADS
ML_V = D_MODEL // ML_HEADS
ML_QKW = 2 * ML_HEADS * ML_QK
ML_VW = ML_HEADS * ML_V
ML_IN = ML_QKW + 2 * ML_VW + 2 * ML_HEADS
CONV_W = 4
GATE_CAP = 15.0

D_FF = -(-(8 * D_MODEL) // (3 * 256)) * 256

kernel_name = "rwkv7_mlstm_interleaved_adaln_trunk"


def _rms(x):
    xf = x.astype(jnp.float32)
    return (xf * lax.rsqrt(jnp.mean(xf * xf, -1, keepdims=True) + EPS)).astype(x.dtype)


def _softcap(t):
    return GATE_CAP * jnp.tanh(t / GATE_CAP)


def _token_shift(x):
    return jnp.pad(x[:, :-1], ((0, 0), (1, 0), (0, 0)))


def _rwkv7_step(state, inp):
    r_t, w_t, k_t, v_t, a_t, b_t = inp
    sa = jnp.einsum('bhvk,bhk->bhv', state, a_t)
    state = state * w_t[:, :, None, :] + sa[..., None] * b_t[:, :, None, :] + v_t[..., None] * k_t[:, :, None, :]
    y = jnp.einsum('bhvk,bhk->bhv', state, r_t)
    return state, y


def _rwkv7_mix(x, mix, w_in, w0, w2, a0, a2, g2, k_k, k_a, r_k, gn_w, gn_b, w_out):
    B, S, D = x.shape
    xx = _token_shift(x) - x
    xs = x[None] + xx[None] * mix[:, None, None, :]
    outs = []
    off = 0
    for i, n in enumerate(RW_SEGS):
        outs.append(xs[i] @ w_in[:, off:off + n])
        off += n
    r, wl, k, v, al, gl = outs
    w_log = -jax.nn.softplus(-(w0 + jnp.tanh(wl) @ w2)) - 0.5
    decay = jnp.exp(-jnp.exp(w_log.astype(jnp.float32)))
    a = jax.nn.sigmoid(a0 + al @ a2)
    g = jax.nn.sigmoid(gl) @ g2
    hs = lambda t: t.reshape(B, S, RW_HEADS, RW_HEAD).astype(jnp.float32)
    kk = hs(k * k_k)
    kk = kk / jnp.maximum(jnp.linalg.norm(kk, axis=-1, keepdims=True), 1e-12)
    k = k * (1.0 + (a - 1.0) * k_a)
    rh, kh, vh, ah, wh = hs(r), hs(k), hs(v), hs(a), hs(decay)
    tm = lambda t: jnp.moveaxis(t, 1, 0)
    state0 = jnp.zeros((B, RW_HEADS, RW_HEAD, RW_HEAD), jnp.float32)
    _, y = lax.scan(_rwkv7_step, state0, (tm(rh), tm(wh), tm(kh), tm(vh), tm(-kk), tm(kk * ah)))
    y = jnp.moveaxis(y, 0, 1)
    mu = jnp.mean(y, -1, keepdims=True)
    var = jnp.mean(jnp.square(y - mu), -1, keepdims=True)
    y = ((y - mu) * lax.rsqrt(var + GN_EPS)).reshape(B, S, D) * gn_w + gn_b
    bonus = (jnp.sum(rh * kh * r_k, -1, keepdims=True) * vh).reshape(B, S, D)
    return ((y + bonus).astype(x.dtype) * g) @ w_out


def _causal_dwconv(x, w, b):
    y = lax.conv_general_dilated(x, w[:, None, :], window_strides=(1,), padding=[(CONV_W - 1, 0)],
                                 dimension_numbers=('NWC', 'WIO', 'NWC'), feature_group_count=x.shape[-1])
    return y + b


def _mlstm_chunk_step(carry, inp):
    C, n, m = carry
    g_c, m_l, C_l, n_l = inp
    m_new = jnp.maximum(g_c + m, m_l)
    sa = jnp.exp(g_c + m - m_new)
    sb = jnp.exp(m_l - m_new)
    C_new = sa[..., None, None] * C + sb[..., None, None] * C_l
    n_new = sa[..., None] * n + sb[..., None] * n_l
    return (C_new, n_new, m_new), (C, n, m)


def _mlstm_mix(x, w_in, conv_w, conv_b, b_i, b_f, hn_w, w_out):
    B, S, D = x.shape
    NC = S // CHUNK
    p = x @ w_in
    qk = jax.nn.silu(_causal_dwconv(p[..., :ML_QKW], conv_w, conv_b))
    v = p[..., ML_QKW:ML_QKW + ML_VW]
    o = p[..., ML_QKW + ML_VW:ML_QKW + 2 * ML_VW]
    gi = p[..., ML_QKW + 2 * ML_VW:ML_QKW + 2 * ML_VW + ML_HEADS]
    gf = p[..., ML_QKW + 2 * ML_VW + ML_HEADS:]
    chunks = lambda t, dh: t.reshape(B, NC, CHUNK, ML_HEADS, dh).transpose(0, 3, 1, 2, 4).astype(jnp.float32)
    q = chunks(qk[..., :ML_QKW // 2], ML_QK) * (ML_QK ** -0.5)
    k = chunks(qk[..., ML_QKW // 2:], ML_QK)
    v = chunks(v, ML_V)
    gate_chunks = lambda t: t.reshape(B, NC, CHUNK, ML_HEADS).transpose(0, 3, 1, 2)
    log_i = gate_chunks(_softcap(gi.astype(jnp.float32) + b_i))
    log_f = gate_chunks(jax.nn.log_sigmoid(_softcap(gf.astype(jnp.float32) + b_f)))
    bcum = jnp.cumsum(log_f, -1)
    causal = jnp.tril(jnp.ones((CHUNK, CHUNK), dtype=bool))
    d_log = jnp.where(causal, bcum[..., :, None] - bcum[..., None, :] + log_i[..., None, :], NEG)
    m_intra = jnp.max(d_log, -1)
    g_tot = bcum[..., -1]
    loc = g_tot[..., None] - bcum + log_i
    m_loc = jnp.max(loc, -1)
    wl = jnp.exp(loc - m_loc[..., None])
    C_loc = jnp.einsum('bhcs,bhcsd,bhcse->bhcde', wl, k, v)
    n_loc = jnp.einsum('bhcs,bhcsd->bhcd', wl, k)
    init = (jnp.zeros((B, ML_HEADS, ML_QK, ML_V), jnp.float32),
            jnp.zeros((B, ML_HEADS, ML_QK), jnp.float32),
            jnp.zeros((B, ML_HEADS), jnp.float32))
    cm = lambda t: jnp.moveaxis(t, 2, 0)
    _, (C_prev, n_prev, m_prev) = lax.scan(_mlstm_chunk_step, init, (cm(g_tot), cm(m_loc), cm(C_loc), cm(n_loc)))
    C_prev, n_prev, m_prev = jnp.moveaxis(C_prev, 0, 2), jnp.moveaxis(n_prev, 0, 2), jnp.moveaxis(m_prev, 0, 2)
    inter = bcum + m_prev[..., None]
    m_t = jnp.maximum(inter, m_intra)
    w_inter = jnp.exp(inter - m_t)
    w_intra = jnp.exp(d_log - m_t[..., None]) * jnp.einsum('bhctd,bhcsd->bhcts', q, k)
    num = w_inter[..., None] * jnp.einsum('bhctd,bhcde->bhcte', q, C_prev) + jnp.einsum('bhcts,bhcse->bhcte', w_intra, v)
    den = w_inter * jnp.einsum('bhctd,bhcd->bhct', q, n_prev) + jnp.sum(w_intra, -1)
    den = jnp.maximum(jnp.abs(den), jnp.exp(-m_t))
    h = num / den[..., None]
    h = h * lax.rsqrt(jnp.mean(h * h, -1, keepdims=True) + EPS) * hn_w[:, None, None, :]
    h = h.transpose(0, 2, 3, 1, 4).reshape(B, S, ML_VW).astype(x.dtype)
    return (h * jax.nn.sigmoid(o)) @ w_out


def _swiglu(x, w_gu, w_down):
    gu = x @ w_gu
    return (jax.nn.silu(gu[..., :D_FF]) * gu[..., D_FF:]) @ w_down


def setup_inputs(seed: int = 0) -> dict:
    key = jax.random.key(seed)
    ks = jax.random.split(key, 32)
    nrm = lambda i, shape, s: jax.random.normal(ks[i], shape, jnp.float32) * s
    D = D_MODEL
    lin = jnp.arange(D, dtype=jnp.float32) / (D - 1)
    return {
        "x": nrm(0, (BATCH, SEQ, D), 1.0),
        "c": nrm(1, (BATCH, D), 1.0),
        "ada_w": nrm(2, (DEPTH, D, 6 * D), 0.3 * D ** -0.5),
        "ada_b": nrm(3, (DEPTH, 6 * D), 0.02),
        "rw_mix": jax.random.uniform(ks[4], (N_RWKV, 6, D), jnp.float32),
        "rw_w_in": nrm(5, (N_RWKV, D, RW_IN), D ** -0.5),
        "rw_w0": jnp.broadcast_to(-6.0 + 5.0 * lin ** 1.5, (N_RWKV, D)) + nrm(6, (N_RWKV, D), 0.1),
        "rw_w2": nrm(7, (N_RWKV, LORA_W, D), 0.3 * LORA_W ** -0.5),
        "rw_a0": nrm(8, (N_RWKV, D), 0.1),
        "rw_a2": nrm(9, (N_RWKV, LORA_A, D), LORA_A ** -0.5),
        "rw_g2": nrm(10, (N_RWKV, LORA_G, D), LORA_G ** -0.5),
        "rw_k_k": 0.85 + nrm(11, (N_RWKV, D), 0.05),
        "rw_k_a": 1.0 + nrm(12, (N_RWKV, D), 0.05),
        "rw_r_k": nrm(13, (N_RWKV, RW_HEADS, RW_HEAD), 0.1),
        "rw_gn_w": 1.0 + nrm(14, (N_RWKV, D), 0.05),
        "rw_gn_b": nrm(15, (N_RWKV, D), 0.02),
        "rw_w_out": nrm(16, (N_RWKV, D, D), D ** -0.5),
        "ml_w_in": nrm(17, (N_MLSTM, D, ML_IN), D ** -0.5),
        "ml_conv_w": nrm(18, (N_MLSTM, CONV_W, ML_QKW), CONV_W ** -0.5),
        "ml_conv_b": nrm(19, (N_MLSTM, ML_QKW), 0.02),
        "ml_b_i": nrm(20, (N_MLSTM, ML_HEADS), 0.1),
        "ml_b_f": jnp.broadcast_to(jnp.linspace(3.0, 6.0, ML_HEADS, dtype=jnp.float32), (N_MLSTM, ML_HEADS)) + nrm(21, (N_MLSTM, ML_HEADS), 0.1),
        "ml_hn_w": 1.0 + nrm(22, (N_MLSTM, ML_HEADS, ML_V), 0.05),
        "ml_w_out": nrm(23, (N_MLSTM, D, D), D ** -0.5),
        "ffn_w_gu": nrm(24, (DEPTH, D, 2 * D_FF), D ** -0.5),
        "ffn_w_down": nrm(25, (DEPTH, D_FF, D), D_FF ** -0.5),
        "final_w": 1.0 + nrm(26, (D,), 0.05),
    }


def reference(x, c, ada_w, ada_b, rw_mix, rw_w_in, rw_w0, rw_w2, rw_a0, rw_a2, rw_g2, rw_k_k, rw_k_a,
              rw_r_k, rw_gn_w, rw_gn_b, rw_w_out, ml_w_in, ml_conv_w, ml_conv_b, ml_b_i, ml_b_f, ml_hn_w,
              ml_w_out, ffn_w_gu, ffn_w_down, final_w):
    c_act = jax.nn.silu(c)
    for i in range(DEPTH):
        mod = c_act @ ada_w[i] + ada_b[i]
        sh1, sc1, g1, sh2, sc2, g2 = [t[:, None, :] for t in jnp.split(mod, 6, axis=-1)]
        h = _rms(x) * (1.0 + sc1) + sh1
        j = i // N_MIXERS
        if i % N_MIXERS == 0:
            y = _rwkv7_mix(h, rw_mix[j], rw_w_in[j], rw_w0[j], rw_w2[j], rw_a0[j], rw_a2[j], rw_g2[j],
                           rw_k_k[j], rw_k_a[j], rw_r_k[j], rw_gn_w[j], rw_gn_b[j], rw_w_out[j])
        else:
            y = _mlstm_mix(h, ml_w_in[j], ml_conv_w[j], ml_conv_b[j], ml_b_i[j], ml_b_f[j], ml_hn_w[j], ml_w_out[j])
        x = x + g1 * y
        h = _rms(x) * (1.0 + sc2) + sh2
        x = x + g2 * _swiglu(h, ffn_w_gu[i], ffn_w_down[i])
    return _rms(x) * final_w
```

```cpp
#include <hip/hip_runtime.h>
#ifndef DUP_SCAN
#define DUP_SCAN 0
#endif
#ifndef DUP_ML
#define DUP_ML 0
#endif
#ifndef DUP_TR
#define DUP_TR 0
#endif
#ifndef DUP_NORM
#define DUP_NORM 0
#endif
#ifndef DUP_BAR
#define DUP_BAR 0
#endif
#include <hip/hip_cooperative_groups.h>
#include <cstdio>
#include <cstdint>
namespace cg = cooperative_groups;

#define LAS __attribute__((address_space(3)))
#define GAS __attribute__((address_space(1)))
typedef unsigned short bf16_t;
typedef short bf16x8 __attribute__((ext_vector_type(8)));
typedef float f32x4 __attribute__((ext_vector_type(4)));
typedef float f32x2 __attribute__((ext_vector_type(2)));
typedef unsigned u32x4 __attribute__((ext_vector_type(4)));
typedef unsigned u32x2 __attribute__((ext_vector_type(2)));

constexpr int T = 16384, D = 1024, SEQ = 4096, FF = 2816, NWAVES = 8, NTHR = 512;
constexpr float EPS = 1e-6f, GN_EPS = 64e-5f;
constexpr size_t MiB = 1u << 20;
constexpr size_t WS_CTL = 255 * MiB;
constexpr size_t WS_WRKV = 0, WS_WL = 6 * MiB, WS_WUP = 8 * MiB, WS_WO0 = 10 * MiB, WS_WGU0 = 12 * MiB, WS_WD0 = 23 * MiB;
constexpr size_t WS_L = 29 * MiB;
constexpr size_t WS_WML = 29 * MiB, WS_WO1 = 35 * MiB, WS_WGU1 = 37 * MiB, WS_WD1 = 48 * MiB;
constexpr size_t WS_MOD = 54 * MiB;
constexpr size_t WS_NLOC = 54 * MiB + 512 * 1024, WS_NPREV = 55 * MiB, WS_MLOC = 55 * MiB + 512 * 1024, WS_GTOT = WS_MLOC + 16384, WS_MPREV = WS_GTOT + 16384;
constexpr size_t WS_RK = 56 * MiB, WS_GATES = 57 * MiB;
constexpr size_t WS_R1 = 58 * MiB, WS_R2 = 154 * MiB;
static_assert(WS_R2 + 96 * MiB <= WS_CTL, "ws map");

__device__ __forceinline__ unsigned f2bf(float f) { unsigned u = __builtin_bit_cast(unsigned, f); return (u + 0x7fffu + ((u >> 16) & 1u)) >> 16; }
__device__ __forceinline__ unsigned pk2(float lo, float hi) { return f2bf(lo) | (f2bf(hi) << 16); }
__device__ __forceinline__ float bflo(unsigned w) { return __builtin_bit_cast(float, w << 16); }
__device__ __forceinline__ float bfhi(unsigned w) { return __builtin_bit_cast(float, w & 0xffff0000u); }
__device__ __forceinline__ float bf2f(bf16_t b) { return __builtin_bit_cast(float, (unsigned)b << 16); }
__device__ __forceinline__ unsigned cvt_pk_bf16(float lo, float hi) { unsigned r; asm volatile("v_cvt_pk_bf16_f32 %0, %1, %2" : "=v"(r) : "v"(lo), "v"(hi)); return r; }
__device__ __forceinline__ float sigmoidf_(float x) { return __builtin_amdgcn_rcpf(1.f + __builtin_amdgcn_exp2f(-1.4426950408889634f * x)); }
__device__ __forceinline__ float siluf_(float x) { return x * __builtin_amdgcn_rcpf(1.f + __builtin_amdgcn_exp2f(-1.4426950408889634f * x)); }
#define LDS_WAIT() asm volatile("s_waitcnt lgkmcnt(0)" ::: "memory")
__device__ __forceinline__ float fma_s(float a, float b, float c) { float r; asm("v_fma_f32 %0, %1, %2, %3" : "=v"(r) : "v"(a), "v"(b), "v"(c)); return r; }
__device__ __forceinline__ float mul_s(float a, float b) { float r; asm("v_mul_f32_e32 %0, %1, %2" : "=v"(r) : "v"(a), "v"(b)); return r; }

template <int CTRL> __device__ __forceinline__ float dpp_mov(float v) { return __builtin_bit_cast(float, __builtin_amdgcn_update_dpp(0, __builtin_bit_cast(int, v), CTRL, 0xf, 0xf, true)); }
__device__ __forceinline__ float red8(float v) { v += dpp_mov<0xB1>(v); v += dpp_mov<0x4E>(v); v += dpp_mov<0x141>(v); return v; }
__device__ __forceinline__ float red16(float v) { v = red8(v); v += dpp_mov<0x140>(v); return v; }
__device__ __forceinline__ float wave_sum(float v) {
#pragma unroll
    for (int o = 1; o < 64; o <<= 1) v += __shfl_xor(v, o);
    return v;
}

namespace pg8 {
constexpr int BM = 256, BK = 64, HALF = 128, HTB = HALF * BK * 2, NXCD = 8, WGM = 8;
__host__ __device__ __forceinline__ int lds_byte(int r, int c) { const int st = (r >> 4) * 2 + (c >> 5), rr = r & 15, cc = c & 31, ob = rr * 64 + cc * 2; return st * 1024 + (ob ^ (((ob >> 9) & 1) << 5)); }
__host__ __device__ __forceinline__ void stage_rc(int b, int& R, int& C) { const int st = b / 1024, sb = b % 1024, swz = sb ^ (((sb >> 9) & 1) << 5); R = (st >> 1) * 16 + swz / 64; C = (st & 1) * 32 + (swz % 64) / 2; }
__host__ __device__ __forceinline__ int perm32(int rho) { const int n = rho >> 4, i = rho & 15; return 8 * (i >> 2) + 4 * n + (i & 3); }
struct Unit { int pm, pn; };
struct Gemm { const bf16_t* A; const bf16_t* Bt; int lda, ldb, K; size_t astep; };
struct StaticOrder {
    int nM, nN, nwg, G, c, cnt;
    __device__ void init(int M, int N, int G_, int c_) { nM = M / BM; nN = N / BM; nwg = nM * nN; G = G_; c = c_; cnt = -1; }
    __device__ void init_sub(int M, int N, int base, int stride, int c_, int cnt_) { nM = M / BM; nN = N / BM; nwg = nM * nN; G = stride; c = base + c_; cnt = cnt_; }
    __device__ bool next(int i, Unit& u) const {
        if (cnt >= 0 && i >= cnt) return false;
        const long L = (long)i * G + c; if (L >= nwg) return false;
        int wgid = (int)L; { const int q = nwg / NXCD, r = nwg % NXCD, xcd = wgid % NXCD, off = wgid / NXCD; wgid = (xcd < r ? xcd * (q + 1) : r * (q + 1) + (xcd - r) * q) + off; }
        const int nig = WGM * nN, gid = wgid / nig, fm = gid * WGM, gsz = (nM - fm) < WGM ? (nM - fm) : WGM;
        u.pm = fm + ((wgid % nig) % gsz); u.pn = (wgid % nig) / gsz; return true;
    }
};

template <class Epi, bool ALIGN_EPI>
__device__ __forceinline__ void gemm_phase(LAS unsigned char* lds, const Gemm g, const StaticOrder& S, const Epi& E) {
    int tid = threadIdx.x; asm volatile("" : "+v"(tid));
    const int wid = __builtin_amdgcn_readfirstlane(tid >> 6), lane = tid & 63, wr = wid >> 2, wc = wid & 3, fr = lane & 15, fq = lane >> 4;
    const int K = g.K, nt = K / BK;
    unsigned voffA[2], voffB[2];
#pragma unroll
    for (int i = 0; i < 2; ++i) { int R, C; stage_rc(tid * 16 + i * 8192, R, C); const int Rb = (R & ~31) + perm32(R & 31);
        voffA[i] = (unsigned)(R * g.lda + C) * 2u; voffB[i] = (unsigned)(Rb * g.ldb + C) * 2u; }
    const size_t kstep = (size_t)(BK * 2);
    const size_t hA = (size_t)HALF * g.lda * 2, hB = (size_t)HALF * g.ldb * 2, tA = 2 * hA, tB = 2 * hB;
    const unsigned ldsw = (unsigned)wid * 1024u;
    const int aoff = lds_byte(wr * 64 + fr, fq * 8), boff = lds_byte(wc * 32 + fr, fq * 8);
#define PG8_SA(b, h) (((b) * 2 + (h)) * HTB)
#define PG8_SB(b, h) ((4 + (b) * 2 + (h)) * HTB)
#define PG8_STAGE(bufoff, gbase, voff) do { _Pragma("unroll") for (int _i = 0; _i < 2; ++_i) \
        __builtin_amdgcn_global_load_lds((const unsigned*)((const char*)(gbase) + (voff)[_i]), (LAS unsigned*)(lds + (bufoff) + ldsw + _i * 8192), 16, 0, 0); } while (0)
#define PG8_LDA(dst, b, h) do { _Pragma("unroll") for (int m = 0; m < 4; ++m) _Pragma("unroll") for (int k = 0; k < 2; ++k) dst[m][k] = *(const LAS bf16x8*)(lds + PG8_SA(b, h) + aoff + m * 2048 + k * 1024); } while (0)
#define PG8_LDB(dst, b, h) do { _Pragma("unroll") for (int n = 0; n < 2; ++n) _Pragma("unroll") for (int k = 0; k < 2; ++k) dst[n][k] = *(const LAS bf16x8*)(lds + PG8_SB(b, h) + boff + n * 2048 + k * 1024); } while (0)
#define PG8_MMA(ai, bj, At, Bt) do { __builtin_amdgcn_s_setprio(1); _Pragma("unroll") for (int m = 0; m < 4; ++m) _Pragma("unroll") for (int n = 0; n < 2; ++n) _Pragma("unroll") for (int k = 0; k < 2; ++k) \
        acc[ai][bj][m][n] = __builtin_amdgcn_mfma_f32_16x16x32_bf16(Bt[n][k], At[m][k], acc[ai][bj][m][n], 0, 0, 0); __builtin_amdgcn_s_setprio(0); } while (0)
#define PG8_WAIT_V(n) asm volatile("s_waitcnt vmcnt(" #n ")" ::: "memory")
#define PG8_WAIT_L(n) asm volatile("s_waitcnt lgkmcnt(" #n ")" ::: "memory")
#define PG8_BAR __builtin_amdgcn_s_barrier()
#define PG8_SCHED __builtin_amdgcn_sched_barrier(0)
    Unit cur, nxt; int ui = 0;
    if (!S.next(0, cur)) return;
    f32x4 acc[2][2][4][2];
#pragma unroll
    for (int a = 0; a < 2; ++a)
#pragma unroll
        for (int b = 0; b < 2; ++b)
#pragma unroll
            for (int m = 0; m < 4; ++m)
#pragma unroll
                for (int n = 0; n < 2; ++n) acc[a][b][m][n] = (f32x4){0.f, 0.f, 0.f, 0.f};
    bf16x8 At[4][2], B0[2][2], B1[2][2];
    const char* cA = (const char*)g.A + (size_t)cur.pm * tA + (size_t)(cur.pn >> 2) * g.astep; const char* cB = (const char*)g.Bt + (size_t)cur.pn * tB;
    PG8_STAGE(PG8_SB(0, 0), cB, voffB); PG8_STAGE(PG8_SB(0, 1), cB + hB, voffB); PG8_STAGE(PG8_SA(0, 0), cA, voffA); PG8_STAGE(PG8_SA(0, 1), cA + hA, voffA);
    if (wr == 1) PG8_BAR;
    PG8_WAIT_V(2); PG8_BAR;
    PG8_STAGE(PG8_SB(1, 0), cB + kstep, voffB); PG8_STAGE(PG8_SA(1, 0), cA + kstep, voffA); PG8_STAGE(PG8_SB(1, 1), cB + hB + kstep, voffB);
    PG8_WAIT_V(6); PG8_BAR;
    for (;;) {
        const bool has_next = S.next(ui + 1, nxt);
        const char* nA = has_next ? (const char*)g.A + (size_t)nxt.pm * tA + (size_t)(nxt.pn >> 2) * g.astep : cA; const char* nB = has_next ? (const char*)g.Bt + (size_t)nxt.pn * tB : cB;
        for (int t = 0; t < nt; t += 2) {
            const bool last = (t == nt - 2);
            const char* a1 = cA + (size_t)(t + 1) * kstep;
            const char* a2 = last ? nA : cA + (size_t)(t + 2) * kstep; const char* b2 = last ? nB : cB + (size_t)(t + 2) * kstep;
            const char* a3 = a2 + kstep; const char* b3 = b2 + kstep;
            PG8_LDB(B0, 0, 0); PG8_LDB(B1, 0, 1); PG8_SCHED; PG8_LDA(At, 0, 0); PG8_STAGE(PG8_SA(1, 1), a1 + hA, voffA);
            PG8_WAIT_V(8); PG8_WAIT_L(0); PG8_BAR; PG8_MMA(0, 0, At, B0); PG8_MMA(0, 1, At, B1); PG8_BAR; PG8_SCHED;
            PG8_LDA(At, 0, 1); PG8_STAGE(PG8_SB(0, 0), b2, voffB); PG8_STAGE(PG8_SB(0, 1), b2 + hB, voffB); PG8_STAGE(PG8_SA(0, 0), a2, voffA);
            PG8_WAIT_V(8); PG8_WAIT_L(0); PG8_BAR; PG8_MMA(1, 0, At, B0); PG8_MMA(1, 1, At, B1); PG8_BAR; PG8_SCHED;
            PG8_LDB(B0, 1, 0); PG8_LDB(B1, 1, 1); PG8_SCHED; PG8_LDA(At, 1, 0); PG8_STAGE(PG8_SA(0, 1), a2 + hA, voffA);
            PG8_WAIT_V(8); PG8_WAIT_L(0); PG8_BAR; PG8_MMA(0, 0, At, B0); PG8_MMA(0, 1, At, B1); PG8_BAR; PG8_SCHED;
            PG8_LDA(At, 1, 1); PG8_STAGE(PG8_SB(1, 0), b3, voffB); PG8_STAGE(PG8_SB(1, 1), b3 + hB, voffB); PG8_STAGE(PG8_SA(1, 0), a3, voffA);
            PG8_WAIT_V(8); PG8_WAIT_L(0); PG8_BAR; PG8_MMA(1, 0, At, B0); PG8_MMA(1, 1, At, B1); PG8_BAR; PG8_SCHED;
        }
        if constexpr (ALIGN_EPI) { if (wr == 0) PG8_BAR; }
        E(acc, cur, wr, wc, fr, fq);
        if (!has_next) break;
#pragma unroll
        for (int a = 0; a < 2; ++a)
#pragma unroll
            for (int b = 0; b < 2; ++b)
#pragma unroll
                for (int m = 0; m < 4; ++m)
#pragma unroll
                    for (int n = 0; n < 2; ++n) acc[a][b][m][n] = (f32x4){0.f, 0.f, 0.f, 0.f};
        cur = nxt; cA = nA; cB = nB; ++ui;
        if constexpr (ALIGN_EPI) { if (wr == 1) PG8_BAR; }
    }
    PG8_WAIT_V(0);
    if constexpr (!ALIGN_EPI) { if (wr == 0) PG8_BAR; }
    PG8_BAR;
#undef PG8_SA
#undef PG8_SB
#undef PG8_STAGE
#undef PG8_LDA
#undef PG8_LDB
#undef PG8_MMA
#undef PG8_WAIT_V
#undef PG8_WAIT_L
#undef PG8_BAR
#undef PG8_SCHED
}

typedef f32x4 Acc[2][2][4][2];
struct EpiBf16 {
    bf16_t* O; int ldc; int mode;
    __device__ __forceinline__ void operator()(const Acc& acc, const Unit& u, int wr, int wc, int fr, int fq) const {
        const int row0 = u.pm * BM + wr * 64 + fr, col0 = u.pn * BM + wc * 32 + 8 * fq;
#pragma unroll
        for (int ai = 0; ai < 2; ++ai)
#pragma unroll
            for (int m = 0; m < 4; ++m) { bf16_t* rowp = O + (size_t)(row0 + ai * HALF + m * 16) * ldc + col0;
#pragma unroll
                for (int bj = 0; bj < 2; ++bj) { f32x4 v0 = acc[ai][bj][m][0], v1 = acc[ai][bj][m][1];
                    int act = 0; if (mode == 1) act = (u.pn == 0) ? (bj == 0 ? 1 : 0) : 2; else if (mode == 2) act = (u.pn >= 8) ? 2 : 0;
                    if (act == 1) {
#pragma unroll
                        for (int i = 0; i < 4; ++i) { v0[i] = tanhf(v0[i]); v1[i] = tanhf(v1[i]); } }
                    else if (act == 2) {
#pragma unroll
                        for (int i = 0; i < 4; ++i) { v0[i] = sigmoidf_(v0[i]); v1[i] = sigmoidf_(v1[i]); } }
                    u32x4 w; w.x = cvt_pk_bf16(v0[0], v0[1]); w.y = cvt_pk_bf16(v0[2], v0[3]); w.z = cvt_pk_bf16(v1[0], v1[1]); w.w = cvt_pk_bf16(v1[2], v1[3]);
                    *(u32x4*)(rowp + bj * HALF) = w; } }
    }
};
struct EpiUp {
    bf16_t* O; const float* w0; const float* a0;
    __device__ __forceinline__ void operator()(const Acc& acc, const Unit& u, int wr, int wc, int fr, int fq) const {
        const int grp = u.pn >> 2;
        const int row0 = u.pm * BM + wr * 64 + fr, col0 = u.pn * BM + wc * 32 + 8 * fq, cc0 = col0 - grp * 1024;
        const float* bp = (grp == 0 ? w0 : a0) + cc0;
#pragma unroll
        for (int bj = 0; bj < 2; ++bj) {
            f32x4 b0 = (f32x4){0.f, 0.f, 0.f, 0.f}, b1 = b0;
            if (grp < 2) { b0 = *(const f32x4*)(bp + bj * HALF); b1 = *(const f32x4*)(bp + bj * HALF + 4); }
#pragma unroll
            for (int ai = 0; ai < 2; ++ai)
#pragma unroll
                for (int m = 0; m < 4; ++m) { bf16_t* rowp = O + (size_t)(row0 + ai * HALF + m * 16) * 3072 + col0;
                    f32x4 v0 = acc[ai][bj][m][0] + b0, v1 = acc[ai][bj][m][1] + b1;
                    if (grp == 0) {
#pragma unroll
                        for (int i = 0; i < 4; ++i) { v0[i] = -0.60653066f * sigmoidf_(v0[i]); v1[i] = -0.60653066f * sigmoidf_(v1[i]); } }
                    else if (grp == 1) {
#pragma unroll
                        for (int i = 0; i < 4; ++i) { v0[i] = sigmoidf_(v0[i]); v1[i] = sigmoidf_(v1[i]); } }
                    u32x4 w; w.x = cvt_pk_bf16(v0[0], v0[1]); w.y = cvt_pk_bf16(v0[2], v0[3]); w.z = cvt_pk_bf16(v1[0], v1[1]); w.w = cvt_pk_bf16(v1[2], v1[3]);
                    *(u32x4*)(rowp + bj * HALF) = w; }
        }
    }
};
struct EpiResid {
    const float* Xin; float* Xout; const float* gate;
    __device__ __forceinline__ void operator()(const Acc& acc, const Unit& u, int wr, int wc, int fr, int fq) const {
        const int row0 = u.pm * BM + wr * 64 + fr, col0 = u.pn * BM + wc * 32 + 8 * fq;
        const float* gp = gate + (size_t)((u.pm * BM) / SEQ) * 6144 + col0;
#pragma unroll
        for (int bj = 0; bj < 2; ++bj) {
            const f32x4 g0 = *(const f32x4*)(gp + bj * HALF), g1 = *(const f32x4*)(gp + bj * HALF + 4);
#pragma unroll
            for (int ai = 0; ai < 2; ++ai)
#pragma unroll
                for (int m = 0; m < 4; ++m) { const size_t ro = (size_t)(row0 + ai * HALF + m * 16) * D + col0 + bj * HALF;
                    const f32x4 x0 = *(const f32x4*)(Xin + ro), x1 = *(const f32x4*)(Xin + ro + 4);
                    *(f32x4*)(Xout + ro) = x0 + g0 * acc[ai][bj][m][0]; *(f32x4*)(Xout + ro + 4) = x1 + g1 * acc[ai][bj][m][1]; }
        }
    }
};
struct EpiSwiglu {
    bf16_t* O;
    __device__ __forceinline__ void operator()(const Acc& acc, const Unit& u, int wr, int wc, int fr, int fq) const {
        const int row0 = u.pm * BM + wr * 64 + fr, col0 = u.pn * HALF + wc * 32 + 8 * fq;
#pragma unroll
        for (int ai = 0; ai < 2; ++ai)
#pragma unroll
            for (int m = 0; m < 4; ++m) { f32x4 v[2];
#pragma unroll
                for (int n = 0; n < 2; ++n)
#pragma unroll
                    for (int i = 0; i < 4; ++i) { const float gt = acc[ai][0][m][n][i]; v[n][i] = siluf_(gt) * acc[ai][1][m][n][i]; }
                u32x4 w; w.x = cvt_pk_bf16(v[0][0], v[0][1]); w.y = cvt_pk_bf16(v[0][2], v[0][3]); w.z = cvt_pk_bf16(v[1][0], v[1][1]); w.w = cvt_pk_bf16(v[1][2], v[1][3]);
                *(u32x4*)(O + (size_t)(row0 + ai * HALF + m * 16) * FF + col0) = w; }
    }
};
}

#define XB_TMO      128
#define XB_XCNT(j)  (256  + 64 * (j))
#define XB_XSUB(j)  (1280 + 64 * (j))
#define XB_XGEN(j)  (2304 + 64 * (j))
#define XB_TOP      3328
#define XB_TOPGEN   3392
#define XCD_BAR_WORDS 3456
#define XB_SPIN_CAP (1u << 20)
__device__ __forceinline__ unsigned xb_ld(unsigned* p)              { return __hip_atomic_load(p, __ATOMIC_RELAXED, __HIP_MEMORY_SCOPE_AGENT); }
__device__ __forceinline__ unsigned xb_add(unsigned* p, unsigned v) { return __hip_atomic_fetch_add(p, v, __ATOMIC_RELAXED, __HIP_MEMORY_SCOPE_AGENT); }
__device__ __forceinline__ unsigned xb_xcc_id() { return (unsigned)__builtin_amdgcn_s_getreg((3 << 11) | 20) & 0xFu; }
#define XB_SPIN(cond, bar) do { unsigned _sp = 0; while (cond) { __builtin_amdgcn_s_sleep(1); \
    if ((++_sp & 255u) == 0u) { if (xb_ld(&(bar)[XB_TMO])) break; if (_sp > XB_SPIN_CAP) { atomicAdd(&(bar)[XB_TMO], 1u); break; } } } } while (0)
struct XcdBarrier { unsigned* bar; unsigned x; volatile LAS unsigned* st; };
__device__ __forceinline__ XcdBarrier xcd_barrier_post(unsigned* bar, volatile LAS unsigned* st) {
    XcdBarrier b; b.bar = bar; b.x = xb_xcc_id(); b.st = st;
    if (threadIdx.x == 0) (void)xb_add(&bar[XB_XCNT(b.x)], 1u);
    return b;
}
__device__ __forceinline__ void xcd_barrier_complete(unsigned* bar, unsigned x, unsigned& nloc, unsigned& nx) {
    const unsigned G = gridDim.x * gridDim.y * gridDim.z;
    unsigned sum, cnt, mine, sp = 0u;
    for (;;) {
        sum = 0u; cnt = 0u; mine = 0u;
#pragma unroll
        for (unsigned j = 0; j < 16; ++j) { const unsigned c = xb_ld(&bar[XB_XCNT(j)]); sum += c; cnt += (c > 0u) ? 1u : 0u; mine = (j == x) ? c : mine; }
        if (sum == G) break;
        __builtin_amdgcn_s_sleep(1);
        if ((++sp & 255u) == 0u) { if (xb_ld(&bar[XB_TMO])) break; if (sp > XB_SPIN_CAP) { atomicAdd(&bar[XB_TMO], 1u); break; } }
    }
    nloc = mine > 0u ? mine : 1u; nx = cnt > 0u ? cnt : 1u;
}
__device__ __forceinline__ void xcd_barrier(const XcdBarrier& b) {
    asm volatile("s_waitcnt vmcnt(0)" ::: "memory");
    __syncthreads();
    if (threadIdx.x == 0) {
        unsigned* bar = b.bar;
        __builtin_amdgcn_s_waitcnt(0);
        unsigned nloc = b.st[0], nx = b.st[1];
        if (nloc == 0u) { xcd_barrier_complete(bar, b.x, nloc, nx); b.st[0] = nloc; b.st[1] = nx; }
        const unsigned old = xb_add(&bar[XB_XSUB(b.x)], 1u);
        const unsigned gen = old / nloc;
        if (old + 1u == (gen + 1u) * nloc) {
            __builtin_amdgcn_fence(__ATOMIC_RELEASE, "agent");
            asm volatile("s_waitcnt vmcnt(0)" ::: "memory");
            const unsigned og = xb_add(&bar[XB_TOP], 1u);
            const unsigned tg = og / nx;
            if (og + 1u == (tg + 1u) * nx) xb_add(&bar[XB_TOPGEN], 1u);
            else XB_SPIN(xb_ld(&bar[XB_TOPGEN]) == tg, bar);
            __builtin_amdgcn_fence(__ATOMIC_ACQUIRE, "agent");
            xb_add(&bar[XB_XGEN(b.x)], 1u);
            asm volatile("s_waitcnt vmcnt(0)" ::: "memory");
        } else {
            XB_SPIN(xb_ld(&bar[XB_XGEN(b.x)]) == gen, bar);
            __builtin_amdgcn_fence(__ATOMIC_ACQUIRE, "agent");
            asm volatile("s_waitcnt vmcnt(0)" ::: "memory");
        }
    }
    __syncthreads();
}

constexpr int RING_BYTES = 131072, MISC_OFF = 151808 + 64, LDS_BYTES = 152576;

constexpr int TR_SCR = 64 * 68 * 4;
__device__ __forceinline__ void tr_job(const float* W, int ldw, int col0, int ncols, int Kp, int kmax, bf16_t* WT, int ldt, int drow0, int dk0, const float* ks, int gu,
                                       LAS float* scr, int& rot, int gw, int NGW, int lane) {
    const int nblk = (ncols + 63) / 64, nitems = (Kp / 64) * nblk;
    int start = gw - rot; if (start < 0) start += NGW;
    for (int it = start; it < nitems; it += NGW) {
        const int kb = it / nblk, nb = it % nblk, k0 = 64 * kb, n0 = 64 * nb, nvalid = (ncols - n0) < 64 ? (ncols - n0) : 64;
        const int n4 = (lane & 15) * 4, kq = lane >> 4;
#pragma unroll 8
        for (int i = 0; i < 16; ++i) { const int kk = 4 * i + kq, k = k0 + kk; f32x4 v = (f32x4){0.f, 0.f, 0.f, 0.f};
            if (k < kmax && n4 < nvalid) { v = *(const f32x4*)(W + (size_t)k * ldw + col0 + n0 + n4); if (ks) v = v * ks[k]; }
            *(LAS f32x4*)(scr + kk * 68 + n4) = v; }
        LDS_WAIT(); asm volatile("" ::: "memory");
        int drow = drow0 + n0;
        if (gu) { int j0 = n0; if (j0 < FF) drow = 256 * (j0 / 128) + (j0 % 128); else { j0 -= FF; drow = 256 * (j0 / 128) + 128 + (j0 % 128); } }
        const int c = lane & 7;
#pragma unroll
        for (int j = 0; j < 8; ++j) { const int n = (lane >> 3) + 8 * j; const LAS float* sp = scr + (8 * c) * 68 + n;
            u32x4 o; o.x = pk2(sp[0 * 68], sp[1 * 68]); o.y = pk2(sp[2 * 68], sp[3 * 68]); o.z = pk2(sp[4 * 68], sp[5 * 68]); o.w = pk2(sp[6 * 68], sp[7 * 68]);
            if (n < nvalid) *(u32x4*)(WT + (size_t)(drow + n) * ldt + dk0 + k0 + 8 * c) = o; }
        LDS_WAIT(); asm volatile("" ::: "memory");
    }
    rot = (rot + nitems) % NGW;
}

struct Args { const float* in[27]; float* out; unsigned char* ws; };

__device__ __forceinline__ void ada_phase(const float* c, const float* ada_w, const float* ada_b, float* MOD, LAS unsigned char* lds, int vcu, int G, int tid, int wave, int lane) {
    LAS float* cact = (LAS float*)lds;
    LAS float* part = (LAS float*)(lds + 16384);
    bool have = false;
    for (int item = vcu; item < 192; item += G) {
        if (!have) { for (int i = tid; i < 4096; i += NTHR) { const float v = c[i]; cact[i] = v / (1.f + expf(-v)); } __syncthreads(); have = true; }
        const int l = item / 96, cb = item % 96;
        const int r4 = lane >> 4, c4 = (lane & 15) * 4;
        const float* Wp = ada_w + (size_t)l * D * 6144 + cb * 64 + c4;
        f32x4 a0 = (f32x4){0.f, 0.f, 0.f, 0.f}, a1 = a0, a2 = a0, a3 = a0;
#pragma unroll 8
        for (int kk = 0; kk < 32; ++kk) { const int k = wave * 128 + 4 * kk + r4; const f32x4 w = *(const f32x4*)(Wp + (size_t)k * 6144);
            a0 += w * cact[k]; a1 += w * cact[1024 + k]; a2 += w * cact[2048 + k]; a3 += w * cact[3072 + k]; }
#pragma unroll
        for (int i = 0; i < 4; ++i) { a0[i] += __shfl_xor(a0[i], 16); a0[i] += __shfl_xor(a0[i], 32); a1[i] += __shfl_xor(a1[i], 16); a1[i] += __shfl_xor(a1[i], 32);
                                      a2[i] += __shfl_xor(a2[i], 16); a2[i] += __shfl_xor(a2[i], 32); a3[i] += __shfl_xor(a3[i], 16); a3[i] += __shfl_xor(a3[i], 32); }
        if (r4 == 0) { *(LAS f32x4*)(part + (wave * 4 + 0) * 64 + c4) = a0; *(LAS f32x4*)(part + (wave * 4 + 1) * 64 + c4) = a1; *(LAS f32x4*)(part + (wave * 4 + 2) * 64 + c4) = a2; *(LAS f32x4*)(part + (wave * 4 + 3) * 64 + c4) = a3; }
        __syncthreads();
        if (tid < 256) { const int b = tid >> 6, cc = tid & 63; float s = 0.f;
#pragma unroll
            for (int w = 0; w < 8; ++w) s += part[(w * 4 + b) * 64 + cc];
            MOD[(size_t)(l * 4 + b) * 6144 + cb * 64 + cc] = s + ada_b[l * 6144 + cb * 64 + cc]; }
        __syncthreads();
    }
}

#define RCOL(j) (512 * ((j) >> 1) + 8 * lane + 4 * ((j) & 1))
__device__ __forceinline__ void st_bf16x8(bf16_t* p, f32x4 a, f32x4 b) { u32x4 w; w.x = pk2(a.x, a.y); w.y = pk2(a.z, a.w); w.z = pk2(b.x, b.y); w.w = pk2(b.z, b.w); *(u32x4*)p = w; }
__device__ __forceinline__ void rms_mod_row(const float* xrow, const float* sc, const float* sh, int lane, f32x4 (&h)[4]) {
    float ss = 0.f;
#pragma unroll
    for (int j = 0; j < 4; ++j) { h[j] = *(const f32x4*)(xrow + RCOL(j)); ss += (h[j].x * h[j].x + h[j].y * h[j].y) + (h[j].z * h[j].z + h[j].w * h[j].w); }
    const float rstd = 1.f / sqrtf(wave_sum(ss) * (1.f / D) + EPS);
#pragma unroll
    for (int j = 0; j < 4; ++j) { const f32x4 a = *(const f32x4*)(sc + RCOL(j)), b = *(const f32x4*)(sh + RCOL(j)); h[j] = h[j] * rstd * (a + 1.f) + b; }
}
__device__ __forceinline__ void st_bf16x4(bf16_t* p, f32x4 v) { u32x2 w; w.x = pk2(v.x, v.y); w.y = pk2(v.z, v.w); *(u32x2*)p = w; }

__device__ __forceinline__ void p1_phase(const float* x, const float* MOD0, const float* mix, bf16_t* XS, bf16_t* HX, int gw, int NGW, int lane) {
    for (int ch = gw; ch < T / 8; ch += NGW) {
        const int row0 = ch * 8, b = row0 / SEQ, has_prev = (row0 % SEQ) != 0, nrows = 8 + has_prev;
        const float* sh = MOD0 + (size_t)b * 6144; const float* sc = sh + 1024;
        const float* base = x + (size_t)(row0 - has_prev) * D;
        f32x4 hp[4], h[4], cur[4], nxt[4];
#pragma unroll
        for (int j = 0; j < 4; ++j) { hp[j] = (f32x4){0.f, 0.f, 0.f, 0.f}; cur[j] = *(const f32x4*)(base + RCOL(j)); nxt[j] = cur[j]; }
        for (int i = 0; i < nrows; ++i) {
            if (i + 1 < nrows) {
#pragma unroll
                for (int j = 0; j < 4; ++j) nxt[j] = *(const f32x4*)(base + (size_t)(i + 1) * D + RCOL(j)); }
            float ss = 0.f;
#pragma unroll
            for (int j = 0; j < 4; ++j) ss += (cur[j].x * cur[j].x + cur[j].y * cur[j].y) + (cur[j].z * cur[j].z + cur[j].w * cur[j].w);
            const float rstd = 1.f / sqrtf(wave_sum(ss) * (1.f / D) + EPS);
            const size_t row = (size_t)(row0 - has_prev + i);
#pragma unroll
            for (int j = 0; j < 4; ++j) { const int col = RCOL(j); const f32x4 a = *(const f32x4*)(sc + col), bb = *(const f32x4*)(sh + col); h[j] = cur[j] * rstd * (a + 1.f) + bb; }
            if (i >= has_prev) {
#pragma unroll
                for (int jp = 0; jp < 4; jp += 2) { const int col = RCOL(jp); f32x4 xx[2], o[2];
#pragma unroll
                    for (int e = 0; e < 2; ++e) xx[e] = hp[jp + e] - h[jp + e];
#pragma unroll
                    for (int e = 0; e < 2; ++e) o[e] = h[jp + e] + xx[e] * *(const f32x4*)(mix + col + 4 * e);
                    st_bf16x8(XS + row * D + col, o[0], o[1]);
#pragma unroll
                    for (int e = 0; e < 2; ++e) o[e] = h[jp + e] + xx[e] * *(const f32x4*)(mix + 2 * D + col + 4 * e);
                    st_bf16x8(XS + (size_t)T * D + row * D + col, o[0], o[1]);
#pragma unroll
                    for (int e = 0; e < 2; ++e) o[e] = h[jp + e] + xx[e] * *(const f32x4*)(mix + 3 * D + col + 4 * e);
                    st_bf16x8(XS + (size_t)2 * T * D + row * D + col, o[0], o[1]);
                    st_bf16x8(HX + row * 2048 + col, h[jp], h[jp + 1]);
                    st_bf16x8(HX + row * 2048 + 1024 + col, xx[0], xx[1]); } }
#pragma unroll
            for (int j = 0; j < 4; ++j) { hp[j] = h[j]; cur[j] = nxt[j]; }
        }
    }
}
__device__ __forceinline__ void norm_phase(const float* X, const float* sh, const float* sc, bf16_t* H, int gw, int NGW, int lane) {
    for (int row0 = gw * 4; row0 < T; row0 += NGW * 4) {
        const int b = row0 / SEQ; f32x4 h[4][4]; float ss[4];
#pragma unroll
        for (int r = 0; r < 4; ++r) { ss[r] = 0.f;
#pragma unroll
            for (int j = 0; j < 4; ++j) h[r][j] = *(const f32x4*)(X + (size_t)(row0 + r) * D + RCOL(j)); }
#pragma unroll
        for (int r = 0; r < 4; ++r)
#pragma unroll
            for (int j = 0; j < 4; ++j) ss[r] += (h[r][j].x * h[r][j].x + h[r][j].y * h[r][j].y) + (h[r][j].z * h[r][j].z + h[r][j].w * h[r][j].w);
#pragma unroll
        for (int o = 1; o < 64; o <<= 1) {
#pragma unroll
            for (int r = 0; r < 4; ++r) ss[r] += __shfl_xor(ss[r], o); }
#pragma unroll
        for (int jp = 0; jp < 4; jp += 2) { const f32x4 a0 = *(const f32x4*)(sc + (size_t)b * 6144 + RCOL(jp)) + 1.f, b0 = *(const f32x4*)(sh + (size_t)b * 6144 + RCOL(jp)),
                                                       a1 = *(const f32x4*)(sc + (size_t)b * 6144 + RCOL(jp + 1)) + 1.f, b1 = *(const f32x4*)(sh + (size_t)b * 6144 + RCOL(jp + 1));
#pragma unroll
            for (int r = 0; r < 4; ++r) { const float rstd = 1.f / sqrtf(ss[r] * (1.f / D) + EPS); st_bf16x8(H + (size_t)(row0 + r) * D + RCOL(jp), h[r][jp] * rstd * a0 + b0, h[r][jp + 1] * rstd * a1 + b1); } }
    }
}
__device__ __forceinline__ void norm_gates_phase(const float* X, const float* sh, const float* sc, const float* w_in, bf16_t* H, float* GATES, LAS unsigned char* lds, int gw, int NGW, int tid, int lane) {
    LAS float* wg = (LAS float*)lds;
    for (int i = tid; i < 1024 * 16; i += NTHR) wg[i] = w_in[(size_t)(i >> 4) * 3088 + 3072 + (i & 15)];
    __syncthreads();
    for (int row = gw; row < T; row += NGW) {
        const int b = row / SEQ; f32x4 h[4];
        rms_mod_row(X + (size_t)row * D, sc + (size_t)b * 6144, sh + (size_t)b * 6144, lane, h);
        asm volatile("" ::: "memory");
        float g[16];
#pragma unroll
        for (int i = 0; i < 16; ++i) g[i] = 0.f;
#pragma unroll
        for (int j = 0; j < 4; ++j) { if ((j & 1) == 0) st_bf16x8(H + (size_t)row * D + RCOL(j), h[j], h[j + 1]);
#pragma unroll
            for (int e = 0; e < 4; ++e) { const LAS f32x4* wp = (const LAS f32x4*)(wg + (RCOL(j) + e) * 16); const float hv = h[j][e];
#pragma unroll
                for (int q = 0; q < 4; ++q) { const f32x4 w = wp[q]; g[4 * q] += hv * w.x; g[4 * q + 1] += hv * w.y; g[4 * q + 2] += hv * w.z; g[4 * q + 3] += hv * w.w; } } }
#pragma unroll
        for (int i = 0; i < 16; ++i) { float v = red16(g[i]);
            v += __builtin_bit_cast(float, __builtin_amdgcn_update_dpp(0, __builtin_bit_cast(int, v), 0x142, 0xa, 0xf, false));
            v += __builtin_bit_cast(float, __builtin_amdgcn_update_dpp(0, __builtin_bit_cast(int, v), 0x143, 0xc, 0xf, false));
            g[i] = v; }
        if (lane == 63) {
#pragma unroll
            for (int q = 0; q < 4; ++q) *(f32x4*)(GATES + (size_t)row * 16 + 4 * q) = (f32x4){g[4 * q], g[4 * q + 1], g[4 * q + 2], g[4 * q + 3]}; }
    }
    __syncthreads();
}
__device__ __forceinline__ void final_norm_phase(const float* X, const float* fw, float* out, int gw, int NGW, int lane) {
    for (int row0 = gw * 4; row0 < T; row0 += NGW * 4) {
        f32x4 h[4][4]; float ss[4];
#pragma unroll
        for (int r = 0; r < 4; ++r) { ss[r] = 0.f;
#pragma unroll
            for (int j = 0; j < 4; ++j) h[r][j] = *(const f32x4*)(X + (size_t)(row0 + r) * D + RCOL(j)); }
#pragma unroll
        for (int r = 0; r < 4; ++r)
#pragma unroll
            for (int j = 0; j < 4; ++j) ss[r] += (h[r][j].x * h[r][j].x + h[r][j].y * h[r][j].y) + (h[r][j].z * h[r][j].z + h[r][j].w * h[r][j].w);
#pragma unroll
        for (int o = 1; o < 64; o <<= 1) {
#pragma unroll
            for (int r = 0; r < 4; ++r) ss[r] += __shfl_xor(ss[r], o); }
#pragma unroll
        for (int j = 0; j < 4; ++j) { const f32x4 w = *(const f32x4*)(fw + RCOL(j));
#pragma unroll
            for (int r = 0; r < 4; ++r) { const float rstd = 1.f / sqrtf(ss[r] * (1.f / D) + EPS); *(f32x4*)(out + (size_t)(row0 + r) * D + RCOL(j)) = h[r][j] * rstd * w; } }
    }
}

constexpr int TC = 32;
constexpr int SC_BUF = 5 * TC * 64 * 4 + TC * 16 * 4 + TC * 256 * 4 + (TC / 2) * 8;
static_assert(2 * SC_BUF <= 151808 && MISC_OFF + 128 <= LDS_BYTES, "scan LDS");
#define SC_BAR() do { asm volatile("s_waitcnt lgkmcnt(0)" ::: "memory"); __builtin_amdgcn_s_barrier(); asm volatile("" ::: "memory"); } while (0)
template <int MODE>
__device__ __forceinline__ void scan_phase(const bf16_t* RKV, const bf16_t* WAG, const float* k_k, const float* k_a, const float* r_k, bf16_t* Y, float* RK, LAS unsigned char* lds, int vcu, int G, int tid, int wave, int lane) {
    for (int item = vcu; item < 256; item += G) {
        const int bh = item >> 2, q = item & 3, b = bh >> 4, h = bh & 15;
        const size_t tok0 = (size_t)b * SEQ;
        if (wave >= 4) {
            const int p = tid - 256, tt = p >> 3, c8 = p & 7, ch = h * 64 + 8 * c8;
            float kkp[8], kap[8], rkp[8];
#pragma unroll
            for (int i = 0; i < 8; ++i) { kkp[i] = k_k[ch + i]; kap[i] = k_a[ch + i]; rkp[i] = r_k[ch + i]; }
            u32x4 lr0, lk0, ld0, la0, lv0 = (u32x4){0u, 0u, 0u, 0u}, lr1, lk1, ld1, la1, lv1 = (u32x4){0u, 0u, 0u, 0u};
            const int vt = p >> 1, vh = p & 1;
#define SC_LOAD(S, chunk) do { const size_t tk = tok0 + (size_t)(chunk) * TC + tt; \
                lr##S = *(const u32x4*)(RKV + tk * 3072 + ch); lk##S = *(const u32x4*)(RKV + tk * 3072 + 1024 + ch); \
                ld##S = *(const u32x4*)(WAG + tk * 3072 + ch); la##S = *(const u32x4*)(WAG + tk * 3072 + 1024 + ch); \
                if (p < 64) lv##S = *(const u32x4*)(RKV + (tok0 + (size_t)(chunk) * TC + vt) * 3072 + 2048 + h * 64 + 16 * q + 8 * vh); } while (0)
#define SC_PREP(S, chunk, bufi) do { LAS float* B_ = (LAS float*)(lds + (bufi) * SC_BUF); \
                float r[8], k[8], dl[8], a[8]; \
                _Pragma("unroll") for (int i = 0; i < 4; ++i) { r[2*i] = bflo(lr##S[i]); r[2*i+1] = bfhi(lr##S[i]); k[2*i] = bflo(lk##S[i]); k[2*i+1] = bfhi(lk##S[i]); \
                    dl[2*i] = bflo(ld##S[i]); dl[2*i+1] = bfhi(ld##S[i]); a[2*i] = bflo(la##S[i]); a[2*i+1] = bfhi(la##S[i]); } \
                float ss = 0.f, rk = 0.f, kq[8], k2[8]; \
                _Pragma("unroll") for (int i = 0; i < 8; ++i) { kq[i] = k[i] * kkp[i]; ss += kq[i] * kq[i]; k2[i] = k[i] * (1.f + (a[i] - 1.f) * kap[i]); rk += r[i] * k2[i] * rkp[i]; } \
                ss = red8(ss); rk = red8(rk); \
                const float inv = __builtin_amdgcn_rcpf(fmaxf(__builtin_amdgcn_sqrtf(ss), 1e-12f)); \
                f32x4 o0, o1; \
                o0 = (f32x4){r[0], r[1], r[2], r[3]}; o1 = (f32x4){r[4], r[5], r[6], r[7]}; *(LAS f32x4*)(B_ + 0 * TC * 64 + tt * 64 + 8 * c8) = o0; *(LAS f32x4*)(B_ + 0 * TC * 64 + tt * 64 + 8 * c8 + 4) = o1; \
                float wv[8], at[8], bt[8], atp[8], mpart = 0.f, npart = 0.f; \
                _Pragma("unroll") for (int i = 0; i < 8; ++i) { wv[i] = __expf(dl[i]); at[i] = -kq[i] * inv; bt[i] = kq[i] * inv * a[i]; } \
                  \
                _Pragma("unroll") for (int i = 0; i < 8; ++i) { const float wp = dpp_mov<0x118>(wv[i]), bp = dpp_mov<0x118>(bt[i]), kp = dpp_mov<0x118>(k2[i]); \
                    atp[i] = (tt & 1) ? at[i] * wp : at[i]; mpart += bp * at[i]; npart += kp * at[i]; } \
                mpart = red8(mpart); npart = red8(npart); \
                if ((tt & 1) && c8 == 0) *(LAS f32x2*)(B_ + 5 * TC * 64 + TC * 16 + TC * 256 + (tt >> 1) * 2) = (f32x2){mpart, npart}; \
                o0 = (f32x4){wv[0], wv[1], wv[2], wv[3]}; o1 = (f32x4){wv[4], wv[5], wv[6], wv[7]}; *(LAS f32x4*)(B_ + 1 * TC * 64 + tt * 64 + 8 * c8) = o0; *(LAS f32x4*)(B_ + 1 * TC * 64 + tt * 64 + 8 * c8 + 4) = o1; \
                o0 = (f32x4){k2[0], k2[1], k2[2], k2[3]}; o1 = (f32x4){k2[4], k2[5], k2[6], k2[7]}; *(LAS f32x4*)(B_ + 2 * TC * 64 + tt * 64 + 8 * c8) = o0; *(LAS f32x4*)(B_ + 2 * TC * 64 + tt * 64 + 8 * c8 + 4) = o1; \
                o0 = (f32x4){atp[0], atp[1], atp[2], atp[3]}; o1 = (f32x4){atp[4], atp[5], atp[6], atp[7]}; *(LAS f32x4*)(B_ + 3 * TC * 64 + tt * 64 + 8 * c8) = o0; *(LAS f32x4*)(B_ + 3 * TC * 64 + tt * 64 + 8 * c8 + 4) = o1; \
                o0 = (f32x4){bt[0], bt[1], bt[2], bt[3]}; o1 = (f32x4){bt[4], bt[5], bt[6], bt[7]}; *(LAS f32x4*)(B_ + 4 * TC * 64 + tt * 64 + 8 * c8) = o0; *(LAS f32x4*)(B_ + 4 * TC * 64 + tt * 64 + 8 * c8 + 4) = o1; \
                if (p < 64) { LAS float* V_ = B_ + 5 * TC * 64 + vt * 16 + 8 * vh; \
                    *(LAS f32x4*)V_ = (f32x4){bflo(lv##S[0]), bfhi(lv##S[0]), bflo(lv##S[1]), bfhi(lv##S[1])}; *(LAS f32x4*)(V_ + 4) = (f32x4){bflo(lv##S[2]), bfhi(lv##S[2]), bflo(lv##S[3]), bfhi(lv##S[3])}; } \
                if (q == 0 && c8 == 0) RK[(tok0 + (size_t)(chunk) * TC + tt) * 16 + h] = rk; } while (0)
#define SC_FLUSH(chunk) do { const LAS float* Yp_ = (const LAS float*)(lds + ((chunk) & 1) * SC_BUF) + 5 * TC * 64 + TC * 16; const int st = p >> 3, pr = (p & 7) * 2; \
                const LAS f32x4* q4 = (const LAS f32x4*)(Yp_ + st * 256 + pr * 16); float ys[2]; \
                _Pragma("unroll") for (int o_ = 0; o_ < 2; ++o_) { const f32x4 t0 = q4[4 * o_], t1 = q4[4 * o_ + 1], t2 = q4[4 * o_ + 2], t3 = q4[4 * o_ + 3]; \
                    ys[o_] = (((t0.x + t0.y) + (t0.z + t0.w)) + ((t1.x + t1.y) + (t1.z + t1.w))) + (((t2.x + t2.y) + (t2.z + t2.w)) + ((t3.x + t3.y) + (t3.z + t3.w))); } \
                *(unsigned*)(Y + (tok0 + (size_t)(chunk) * TC + st) * D + h * 64 + 16 * q + pr) = pk2(ys[0], ys[1]); } while (0)
            SC_LOAD(0, 0); SC_PREP(0, 0, 0); SC_LOAD(1, 1);
            SC_BAR();
            for (int cidx = 0; cidx < SEQ / TC; cidx += 2) {
                if (cidx >= 1) SC_FLUSH(cidx - 1);
                SC_PREP(1, cidx + 1, 1);
                if (cidx + 2 < SEQ / TC) SC_LOAD(0, cidx + 2);
                SC_BAR();
                SC_FLUSH(cidx);
                if (cidx + 2 < SEQ / TC) { SC_PREP(0, cidx + 2, 0); if (cidx + 3 < SEQ / TC) SC_LOAD(1, cidx + 3); }
                SC_BAR();
            }
            SC_FLUSH(SEQ / TC - 1);
#undef SC_FLUSH
#undef SC_LOAD
#undef SC_PREP
        } else {
            const int j = lane & 15, lr = 4 * wave + (lane >> 4);
            f32x2 S01 = (f32x2){0.f, 0.f}, S23 = (f32x2){0.f, 0.f};
            SC_BAR();
#define SC_LDP(X, k) do { \
                asm volatile("ds_read_b128 %0, %1 offset:%2" : "=v"(ae##X) : "v"(aB), "n"(24576 + (2 * (k)) * 256)); \
                asm volatile("ds_read_b128 %0, %1 offset:%2" : "=v"(ao##X) : "v"(aB), "n"(24576 + (2 * (k) + 1) * 256)); \
                asm volatile("ds_read_b64 %0, %1 offset:%2" : "=v"(mn##X) : "v"(aM), "n"((k) * 8)); \
                asm volatile("ds_read_b32 %0, %1 offset:%2" : "=v"(ve##X) : "v"(aV), "n"((2 * (k)) * 64)); \
                asm volatile("ds_read_b32 %0, %1 offset:%2" : "=v"(vo##X) : "v"(aV), "n"((2 * (k) + 1) * 64)); \
                asm volatile("ds_read_b128 %0, %1 offset:%2" : "=v"(we##X) : "v"(aB), "n"(8192 + (2 * (k)) * 256)); \
                asm volatile("ds_read_b128 %0, %1 offset:%2" : "=v"(ke##X) : "v"(aB), "n"(16384 + (2 * (k)) * 256)); \
                asm volatile("ds_read_b128 %0, %1 offset:%2" : "=v"(be##X) : "v"(aB), "n"(32768 + (2 * (k)) * 256)); \
                asm volatile("ds_read_b128 %0, %1 offset:%2" : "=v"(re##X) : "v"(aB), "n"((2 * (k)) * 256)); \
                asm volatile("ds_read_b128 %0, %1 offset:%2" : "=v"(wo##X) : "v"(aB), "n"(8192 + (2 * (k) + 1) * 256)); \
                asm volatile("ds_read_b128 %0, %1 offset:%2" : "=v"(ko##X) : "v"(aB), "n"(16384 + (2 * (k) + 1) * 256)); \
                asm volatile("ds_read_b128 %0, %1 offset:%2" : "=v"(bo##X) : "v"(aB), "n"(32768 + (2 * (k) + 1) * 256)); \
                asm volatile("ds_read_b128 %0, %1 offset:%2" : "=v"(ro##X) : "v"(aB), "n"((2 * (k) + 1) * 256)); } while (0)
#define SC_WAIT(X, N) asm volatile("s_waitcnt lgkmcnt(" #N ")" : "+v"(ae##X), "+v"(ao##X), "+v"(mn##X), "+v"(ve##X), "+v"(vo##X), "+v"(we##X), "+v"(ke##X), "+v"(be##X), "+v"(re##X), "+v"(wo##X), "+v"(ko##X), "+v"(bo##X), "+v"(ro##X))
#define SC_PAIR(X, k) do { \
                const f32x2 pe = S01 * (f32x2){ae##X.x, ae##X.y} + S23 * (f32x2){ae##X.z, ae##X.w}; \
                const f32x2 po = S01 * (f32x2){ao##X.x, ao##X.y} + S23 * (f32x2){ao##X.z, ao##X.w}; \
                const float ue = red16(pe.x + pe.y), rawo = red16(po.x + po.y); \
                S01 = S01 * (f32x2){we##X.x, we##X.y} + (f32x2){ke##X.x, ke##X.y} * ve##X; S23 = S23 * (f32x2){we##X.z, we##X.w} + (f32x2){ke##X.z, ke##X.w} * ve##X; \
                S01 = S01 + (f32x2){be##X.x, be##X.y} * ue; S23 = S23 + (f32x2){be##X.z, be##X.w} * ue; \
                { const f32x2 py = S01 * (f32x2){re##X.x, re##X.y} + S23 * (f32x2){re##X.z, re##X.w}; const float yv = py.x + py.y; \
                  asm volatile("ds_write_b32 %0, %1 offset:%2" :: "v"(aY), "v"(yv), "n"((2 * (k)) * 1024)); } \
                const float uo = rawo + mn##X.x * ue + mn##X.y * ve##X; \
                S01 = S01 * (f32x2){wo##X.x, wo##X.y} + (f32x2){ko##X.x, ko##X.y} * vo##X; S23 = S23 * (f32x2){wo##X.z, wo##X.w} + (f32x2){ko##X.z, ko##X.w} * vo##X; \
                S01 = S01 + (f32x2){bo##X.x, bo##X.y} * uo; S23 = S23 + (f32x2){bo##X.z, bo##X.w} * uo; \
                { const f32x2 py = S01 * (f32x2){ro##X.x, ro##X.y} + S23 * (f32x2){ro##X.z, ro##X.w}; const float yv = py.x + py.y; \
                  asm volatile("ds_write_b32 %0, %1 offset:%2" :: "v"(aY), "v"(yv), "n"((2 * (k) + 1) * 1024)); } } while (0)
            static_assert(TC == 32, "scan step loop is written for 32-step chunks");
            for (int cidx = 0; cidx < SEQ / TC; ++cidx) {
                unsigned aB = (unsigned)(cidx & 1) * SC_BUF + 16u * j;
                unsigned aV = (unsigned)(cidx & 1) * SC_BUF + 5 * TC * 64 * 4 + 4u * lr;
                unsigned aY = (unsigned)(cidx & 1) * SC_BUF + 5 * TC * 64 * 4 + TC * 16 * 4 + 4u * tid;
                unsigned aM = (unsigned)(cidx & 1) * SC_BUF + 5 * TC * 64 * 4 + TC * 16 * 4 + TC * 256 * 4;
                f32x4 aeA, aoA, weA, keA, beA, reA, woA, koA, boA, roA, aeB, aoB, weB, keB, beB, reB, woB, koB, boB, roB; f32x2 mnA, mnB; float veA, voA, veB, voB;
                SC_LDP(A, 0);
                SC_WAIT(A, 0); SC_LDP(B, 1); SC_PAIR(A, 0); SC_WAIT(B, 2); SC_LDP(A, 2); SC_PAIR(B, 1);
#define SC_IT(k0) SC_WAIT(A, 2); SC_LDP(B, (k0) + 1); SC_PAIR(A, (k0)); SC_WAIT(B, 2); SC_LDP(A, (k0) + 2); SC_PAIR(B, (k0) + 1);
                SC_IT(2) SC_IT(4) SC_IT(6) SC_IT(8) SC_IT(10) SC_IT(12)
#undef SC_IT
                SC_WAIT(A, 2); SC_LDP(B, 15); SC_PAIR(A, 14); SC_WAIT(B, 2); SC_PAIR(B, 15);
                asm volatile("s_waitcnt lgkmcnt(0)" ::: "memory");
                SC_BAR();
            }
#undef SC_LDP
#undef SC_PAIR
#undef SC_WAIT
        }
        __syncthreads();
    }
}

__device__ __forceinline__ void gn_phase(const bf16_t* Y, const bf16_t* RKV, const bf16_t* WAG, const float* RK, const float* gn_w, const float* gn_b, bf16_t* OUTA, int gw, int NGW, int lane) {
    const int hh = lane >> 3, c8 = lane & 7;
    for (int it = gw; it < T * 2; it += NGW) {
        const size_t tok = it >> 1; const int half = it & 1, h = half * 8 + hh, ch = h * 64 + 8 * c8;
        const u32x4 ly = *(const u32x4*)(Y + tok * D + ch), lv = *(const u32x4*)(RKV + tok * 3072 + 2048 + ch), lg = *(const u32x4*)(WAG + tok * 3072 + 2048 + ch);
        float y[8], v[8], g[8];
#pragma unroll
        for (int i = 0; i < 4; ++i) { y[2*i] = bflo(ly[i]); y[2*i+1] = bfhi(ly[i]); v[2*i] = bflo(lv[i]); v[2*i+1] = bfhi(lv[i]); g[2*i] = bflo(lg[i]); g[2*i+1] = bfhi(lg[i]); }
        float s = 0.f;
#pragma unroll
        for (int i = 0; i < 8; ++i) s += y[i];
        const float mu = red8(s) * (1.f / 64.f); float s2 = 0.f;
#pragma unroll
        for (int i = 0; i < 8; ++i) { y[i] -= mu; s2 += y[i] * y[i]; }
        const float rstd = __builtin_amdgcn_rsqf(red8(s2) * (1.f / 64.f) + GN_EPS), rk = RK[tok * 16 + h];
        const f32x4 w0 = *(const f32x4*)(gn_w + ch), w1 = *(const f32x4*)(gn_w + ch + 4), b0 = *(const f32x4*)(gn_b + ch), b1 = *(const f32x4*)(gn_b + ch + 4);
        float o[8];
#pragma unroll
        for (int i = 0; i < 8; ++i) { const float gw_ = i < 4 ? w0[i] : w1[i - 4], gb_ = i < 4 ? b0[i] : b1[i - 4]; o[i] = (y[i] * rstd * gw_ + gb_ + rk * v[i]) * g[i]; }
        u32x4 w; w.x = pk2(o[0], o[1]); w.y = pk2(o[2], o[3]); w.z = pk2(o[4], o[5]); w.w = pk2(o[6], o[7]);
        *(u32x4*)(OUTA + tok * D + ch) = w;
    }
}

__device__ __forceinline__ float softcap15(float x) { return 15.f * tanhf(x * (1.f / 15.f)); }
__device__ __forceinline__ float logsig(float x) { return fminf(x, 0.f) - log1pf(expf(-fabsf(x))); }
__device__ __forceinline__ float scan_add(float v, int lane) {
#pragma unroll
    for (int o = 1; o < 64; o <<= 1) { const float t = __shfl_up(v, o); if (lane >= o) v += t; }
    return v;
}
__device__ __forceinline__ float scan_max(float v, int lane) {
#pragma unroll
    for (int o = 1; o < 64; o <<= 1) { const float t = __shfl_up(v, o); if (lane >= o) v = fmaxf(v, t); }
    return v;
}
__device__ __forceinline__ float wave_max(float v) {
#pragma unroll
    for (int o = 1; o < 64; o <<= 1) v = fmaxf(v, __shfl_xor(v, o));
    return v;
}
__device__ __forceinline__ void conv8_raw(const u32x4 (&tap)[4], int ch, const LAS float* cwl, const LAS float* cbl, float (&o)[8]) {
    const f32x4 b0 = *(const LAS f32x4*)(cbl + ch), b1 = *(const LAS f32x4*)(cbl + ch + 4);
#pragma unroll
    for (int i = 0; i < 8; ++i) o[i] = i < 4 ? b0[i] : b1[i - 4];
#pragma unroll
    for (int jt = 0; jt < 4; ++jt) {
        const u32x4 l = tap[jt];
        const f32x4 w0 = *(const LAS f32x4*)(cwl + jt * 1024 + ch), w1 = *(const LAS f32x4*)(cwl + jt * 1024 + ch + 4);
        o[0] += w0.x * bflo(l.x); o[1] += w0.y * bfhi(l.x); o[2] += w0.z * bflo(l.y); o[3] += w0.w * bfhi(l.y);
        o[4] += w1.x * bflo(l.z); o[5] += w1.y * bfhi(l.z); o[6] += w1.z * bflo(l.w); o[7] += w1.w * bfhi(l.w);
    }
#pragma unroll
    for (int i = 0; i < 8; ++i) o[i] = siluf_(o[i]);
}
#define ML_TAPS(dst, tokbase, sposbase, chan) do { _Pragma("unroll") for (int jt_ = 0; jt_ < 4; ++jt_) \
    dst[jt_] = ((sposbase) - 3 + jt_ >= 0) ? *(const u32x4*)(P + ((tokbase) - 3 + jt_) * 3072 + (chan)) : (u32x4){0u, 0u, 0u, 0u}; } while (0)
constexpr int LS = 144;
constexpr int ML_CW_OFF = 102400;
__device__ __forceinline__ void ml_local_phase(const bf16_t* P, const float* GATES, const float* cw, const float* cb, const float* b_i, const float* b_f,
                                               float* CLOC, float* NLOC, float* MLOC, float* GTOT, LAS unsigned char* lds, int vcu, int G, int tid, int wave, int lane) {
    LAS unsigned char* Kt = lds; LAS unsigned char* VWt = lds + 64 * LS; LAS float* wls = (LAS float*)(lds + 192 * LS);
    LAS float* cwl = (LAS float*)(lds + ML_CW_OFF); LAS float* cbl = cwl + 4096;
    for (int i = tid; i < 4096; i += NTHR) cwl[i] = cw[i];
    for (int i = tid; i < 1024; i += NTHR) cbl[i] = cb[i];
    const int fr = lane & 15, fq = lane >> 4;
    u32x4 rk[4], rv[2]; float rgi = 0.f, rgf = 0.f;
#define ML12_LOAD(uu) do { const int c_ = (uu) & 63, h_ = ((uu) >> 6) & 7, b_ = (uu) >> 9; const size_t t0_ = (size_t)b_ * SEQ + (size_t)c_ * 64; \
        { const int s_ = tid >> 3, c8_ = tid & 7; ML_TAPS(rk, t0_ + s_, c_ * 64 + s_, 512 + h_ * 64 + 8 * c8_); } \
        _Pragma("unroll") for (int i_ = 0; i_ < 2; ++i_) rv[i_] = *(const u32x4*)(P + (t0_ + lane) * 3072 + 1024 + h_ * 128 + 8 * (wave + 8 * i_)); \
        if (wave == 0) { rgi = GATES[(t0_ + lane) * 16 + h_]; rgf = GATES[(t0_ + lane) * 16 + 8 + h_]; } } while (0)
    if (vcu < 2048) ML12_LOAD(vcu);
    __syncthreads();
    for (int u = vcu; u < 2048; u += G) {
        const int h = (u >> 6) & 7;
        if (wave == 0) {
            const float li = softcap15(rgi + b_i[h]), lf = logsig(softcap15(rgf + b_f[h]));
            const float bc = scan_add(lf, lane), gt = __shfl(bc, 63), loc = gt - bc + li, ml = wave_max(loc);
            wls[lane] = expf(loc - ml);
            if (lane == 0) { MLOC[u] = ml; GTOT[u] = gt; }
        }
        { const int s = tid >> 3, c8 = tid & 7; float kv[8];
          conv8_raw(rk, 512 + h * 64 + 8 * c8, cwl, cbl, kv);
#pragma unroll
          for (int i = 0; i < 8; ++i) *(LAS bf16_t*)(Kt + (8 * c8 + i) * LS + 2 * s) = (bf16_t)f2bf(kv[i]); }
        __syncthreads();
#pragma unroll
        for (int i = 0; i < 2; ++i) { const int s = lane, e8 = wave + 8 * i; const float wl = wls[s]; const u32x4 l = rv[i];
#pragma unroll
            for (int k = 0; k < 4; ++k) { *(LAS bf16_t*)(VWt + (8 * e8 + 2 * k) * LS + 2 * s) = (bf16_t)f2bf(bflo(l[k]) * wl); *(LAS bf16_t*)(VWt + (8 * e8 + 2 * k + 1) * LS + 2 * s) = (bf16_t)f2bf(bfhi(l[k]) * wl); } }
        if (u + G < 2048) ML12_LOAD(u + G);
        __syncthreads();
        { f32x4 acc[4];
#pragma unroll
          for (int n = 0; n < 4; ++n) acc[n] = (f32x4){0.f, 0.f, 0.f, 0.f};
#pragma unroll
          for (int ks = 0; ks < 2; ++ks) { const bf16x8 af = *(const LAS bf16x8*)(VWt + (16 * wave + fr) * LS + (ks * 32 + 8 * fq) * 2);
#pragma unroll
              for (int n = 0; n < 4; ++n) { const bf16x8 bfr = *(const LAS bf16x8*)(Kt + (16 * n + fr) * LS + (ks * 32 + 8 * fq) * 2);
                  acc[n] = __builtin_amdgcn_mfma_f32_16x16x32_bf16(bfr, af, acc[n], 0, 0, 0); } }
#pragma unroll
          for (int n = 0; n < 4; ++n) *(f32x4*)(CLOC + (size_t)u * 8192 + (16 * wave + fr) * 64 + 16 * n + 4 * fq) = acc[n]; }
        if (tid < 64) { float s_ = 0.f;
            for (int s = 0; s < 64; ++s) s_ += wls[s] * bf2f(*(const LAS bf16_t*)(Kt + tid * LS + 2 * s));
            NLOC[(size_t)u * 64 + tid] = s_; }
        __syncthreads();
    }
#undef ML12_LOAD
}
__device__ __forceinline__ void ml_scan_phase(const float* __restrict__ CLOC, const float* __restrict__ NLOC, const float* __restrict__ MLOC, const float* __restrict__ GTOT,
                                              bf16_t* __restrict__ CPT, float* __restrict__ NPREV, float* __restrict__ MPREV, int vcu, int G, int tid) {
    for (int it = vcu; it < 256; it += G) {
        const int bh = it >> 3, part = it & 7;
        if (tid >= 256) continue;
        const int idx = part * 1024 + 4 * tid;
        f32x4 C = (f32x4){0.f, 0.f, 0.f, 0.f}; float m = 0.f, nn = 0.f;
        const bool do_n = (part == 0 && tid < 64);
        for (int c0 = 0; c0 < 64; c0 += 16) {
            f32x4 cl[16]; float gc[16], ml[16], nl[16];
#pragma unroll
            for (int i = 0; i < 16; ++i) { const int u = bh * 64 + c0 + i; cl[i] = *(const f32x4*)(CLOC + (size_t)u * 8192 + idx); gc[i] = GTOT[u]; ml[i] = MLOC[u]; nl[i] = do_n ? NLOC[(size_t)u * 64 + tid] : 0.f; }
#pragma unroll
            for (int i = 0; i < 16; ++i) { const int u = bh * 64 + c0 + i;
                u32x2 o; o.x = pk2(C.x, C.y); o.y = pk2(C.z, C.w);
                *(u32x2*)(CPT + (size_t)u * 8192 + idx) = o;
                const float mn = fmaxf(gc[i] + m, ml[i]), sa = expf(gc[i] + m - mn), sb = expf(ml[i] - mn);
                if (do_n) { NPREV[(size_t)u * 64 + tid] = nn; nn = sa * nn + sb * nl[i]; if (tid == 0) MPREV[u] = m; }
                C = C * sa + cl[i] * sb; m = mn; }
        }
    }
}
__device__ __forceinline__ void ml_out_phase(const bf16_t* P, const float* GATES, const float* cw, const float* cb, const float* b_i, const float* b_f, const float* hn_w,
                                             const bf16_t* CPT, const float* NPREV, const float* MPREV, bf16_t* OUTA, LAS unsigned char* lds, int vcu, int G, int tid, int wave, int lane) {
    LAS unsigned char* Qs = lds; LAS unsigned char* Ks = lds + 64 * LS; LAS unsigned char* Vt = lds + 128 * LS; LAS unsigned char* CP = lds + 256 * LS; LAS unsigned char* Wi = lds + 384 * LS;
    LAS float* Ho = (LAS float*)(lds + 448 * LS);
    LAS float* sc_ = (LAS float*)(lds + 448 * LS + 64 * 132 * 4);
    static_assert(448 * LS + 64 * 132 * 4 + 1280 <= ML_CW_OFF, "mLSTM LDS map");
    LAS float* cwl = (LAS float*)(lds + ML_CW_OFF); LAS float* cbl = cwl + 4096;
    for (int i = tid; i < 4096; i += NTHR) cwl[i] = cw[i];
    for (int i = tid; i < 1024; i += NTHR) cbl[i] = cb[i];
    const int fr = lane & 15, fq = lane >> 4;
    u32x4 rq[4], rk[4], rv[2], rc[2], ro[2]; float rgi = 0.f, rgf = 0.f, rmp = 0.f, rnp = 0.f;
#define ML14_LOAD(uu) do { const int c_ = (uu) & 63, h_ = ((uu) >> 6) & 7, b_ = (uu) >> 9; const size_t t0_ = (size_t)b_ * SEQ + (size_t)c_ * 64; \
        { const int s_ = tid >> 3, c8_ = tid & 7; ML_TAPS(rq, t0_ + s_, c_ * 64 + s_, h_ * 64 + 8 * c8_); ML_TAPS(rk, t0_ + s_, c_ * 64 + s_, 512 + h_ * 64 + 8 * c8_); } \
        _Pragma("unroll") for (int i_ = 0; i_ < 2; ++i_) { rv[i_] = *(const u32x4*)(P + (t0_ + lane) * 3072 + 1024 + h_ * 128 + 8 * (wave + 8 * i_)); \
            const int it_ = tid + NTHR * i_; rc[i_] = *(const u32x4*)(CPT + (size_t)(uu) * 8192 + (it_ >> 3) * 64 + 8 * (it_ & 7)); } \
        if (wave == 0) { rgi = GATES[(t0_ + lane) * 16 + h_]; rgf = GATES[(t0_ + lane) * 16 + 8 + h_]; rmp = MPREV[(uu)]; rnp = NPREV[(size_t)(uu) * 64 + lane]; } } while (0)
#define ML14_LOAD_O(uu) do { const int c_ = (uu) & 63, h_ = ((uu) >> 6) & 7, b_ = (uu) >> 9; const size_t tok_ = (size_t)b_ * SEQ + (size_t)c_ * 64 + (tid >> 3); \
        ro[0] = *(const u32x4*)(P + tok_ * 3072 + 2048 + h_ * 128 + 16 * (tid & 7)); ro[1] = *(const u32x4*)(P + tok_ * 3072 + 2048 + h_ * 128 + 16 * (tid & 7) + 8); } while (0)
    if (vcu < 2048) { ML14_LOAD(vcu); ML14_LOAD_O(vcu); }
    __syncthreads();
    for (int u = vcu; u < 2048; u += G) {
        const int c = u & 63, h = (u >> 6) & 7, b = u >> 9;
        const size_t t0 = (size_t)b * SEQ + (size_t)c * 64;
        if (wave == 0) {
            const float li = softcap15(rgi + b_i[h]), lf = logsig(softcap15(rgf + b_f[h]));
            const float bc = scan_add(lf, lane), cm = scan_max(li - bc, lane);
            const float inter = bc + rmp, mt = fmaxf(inter, bc + cm);
            sc_[lane] = bc; sc_[64 + lane] = li; sc_[128 + lane] = mt; sc_[192 + lane] = expf(inter - mt); sc_[256 + lane] = rnp;
        }
        { const int s = tid >> 3, c8 = tid & 7; float v[8];
          conv8_raw(rq, h * 64 + 8 * c8, cwl, cbl, v);
          u32x4 w; w.x = pk2(v[0] * 0.125f, v[1] * 0.125f); w.y = pk2(v[2] * 0.125f, v[3] * 0.125f); w.z = pk2(v[4] * 0.125f, v[5] * 0.125f); w.w = pk2(v[6] * 0.125f, v[7] * 0.125f);
          *(LAS u32x4*)(Qs + s * LS + 16 * c8) = w;
          conv8_raw(rk, 512 + h * 64 + 8 * c8, cwl, cbl, v);
          w.x = pk2(v[0], v[1]); w.y = pk2(v[2], v[3]); w.z = pk2(v[4], v[5]); w.w = pk2(v[6], v[7]);
          *(LAS u32x4*)(Ks + s * LS + 16 * c8) = w; }
#pragma unroll
        for (int i = 0; i < 2; ++i) { const int s = lane, e8 = wave + 8 * i; const u32x4 l = rv[i];
#pragma unroll
            for (int k = 0; k < 4; ++k) { *(LAS bf16_t*)(Vt + (8 * e8 + 2 * k) * LS + 2 * s) = (bf16_t)(l[k] & 0xffffu); *(LAS bf16_t*)(Vt + (8 * e8 + 2 * k + 1) * LS + 2 * s) = (bf16_t)(l[k] >> 16); } }
#pragma unroll
        for (int i = 0; i < 2; ++i) { const int it = tid + NTHR * i, e = it >> 3, cc = it & 7; *(LAS u32x4*)(CP + e * LS + 16 * cc) = rc[i]; }
        if (u + G < 2048) ML14_LOAD(u + G);
        __syncthreads();
        const int mt_ = wave >> 1, nh = wave & 1;
        bf16x8 qf[2];
#pragma unroll
        for (int ks = 0; ks < 2; ++ks) qf[ks] = *(const LAS bf16x8*)(Qs + (16 * mt_ + fr) * LS + (ks * 32 + 8 * fq) * 2);
        {
            const int t = 16 * mt_ + fr; const float bct = sc_[t], mtt = sc_[128 + t];
#pragma unroll
            for (int n = 0; n < 2; ++n) { f32x4 acc = (f32x4){0.f, 0.f, 0.f, 0.f}; const int s0 = 16 * (2 * nh + n);
#pragma unroll
                for (int ks = 0; ks < 2; ++ks) { const bf16x8 kf = *(const LAS bf16x8*)(Ks + (s0 + fr) * LS + (ks * 32 + 8 * fq) * 2); acc = __builtin_amdgcn_mfma_f32_16x16x32_bf16(kf, qf[ks], acc, 0, 0, 0); }
                float wv[4];
#pragma unroll
                for (int j = 0; j < 4; ++j) { const int s = s0 + 4 * fq + j; wv[j] = (s <= t) ? __expf(bct - sc_[s] + sc_[64 + s] - mtt) * acc[j] : 0.f; }
                u32x2 w; w.x = pk2(wv[0], wv[1]); w.y = pk2(wv[2], wv[3]);
                *(LAS u32x2*)(Wi + t * LS + (s0 + 4 * fq) * 2) = w; }
        }
        __syncthreads();
        {
            const int t = 16 * mt_ + fr; const float wint = sc_[192 + t];
            bf16x8 wf[2];
#pragma unroll
            for (int ks = 0; ks < 2; ++ks) wf[ks] = *(const LAS bf16x8*)(Wi + (16 * mt_ + fr) * LS + (ks * 32 + 8 * fq) * 2);
#pragma unroll
            for (int n = 0; n < 4; ++n) { const int e0 = 16 * (4 * nh + n); f32x4 a1 = (f32x4){0.f, 0.f, 0.f, 0.f}, a2 = (f32x4){0.f, 0.f, 0.f, 0.f};
#pragma unroll
                for (int ks = 0; ks < 2; ++ks) { const bf16x8 cf = *(const LAS bf16x8*)(CP + (e0 + fr) * LS + (ks * 32 + 8 * fq) * 2), vf = *(const LAS bf16x8*)(Vt + (e0 + fr) * LS + (ks * 32 + 8 * fq) * 2);
                    a1 = __builtin_amdgcn_mfma_f32_16x16x32_bf16(cf, qf[ks], a1, 0, 0, 0); a2 = __builtin_amdgcn_mfma_f32_16x16x32_bf16(vf, wf[ks], a2, 0, 0, 0); }
                *(LAS f32x4*)(Ho + t * 132 + e0 + 4 * fq) = a1 * wint + a2; }
        }
        __syncthreads();
        { const int t = tid >> 3, p = tid & 7; float d1 = 0.f, d2 = 0.f;
#pragma unroll
          for (int i = 0; i < 8; ++i) { d1 += bf2f(*(const LAS bf16_t*)(Wi + t * LS + 2 * (8 * p + i))); d2 += bf2f(*(const LAS bf16_t*)(Qs + t * LS + 2 * (8 * p + i))) * sc_[256 + 8 * p + i]; }
          float den = red8(d1 + sc_[192 + t] * d2);
          den = fmaxf(fabsf(den), expf(-sc_[128 + t]));
          const float rden = __builtin_amdgcn_rcpf(den); float hv[16], ss = 0.f;
#pragma unroll
          for (int i = 0; i < 4; ++i) { const f32x4 x4 = *(const LAS f32x4*)(Ho + t * 132 + 16 * p + 4 * i);
#pragma unroll
              for (int k = 0; k < 4; ++k) { hv[4 * i + k] = x4[k] * rden; ss += hv[4 * i + k] * hv[4 * i + k]; } }
          const float scl = __builtin_amdgcn_rsqf(red8(ss) * (1.f / 128.f) + EPS);
          const size_t tok = t0 + t; const int ch = h * 128 + 16 * p;
          const u32x4 o0 = ro[0], o1 = ro[1];
          u32x4 w0, w1;
#pragma unroll
          for (int i = 0; i < 4; ++i) { const f32x4 hw = *(const f32x4*)(hn_w + ch + 4 * i);
              const unsigned ow0 = i < 2 ? o0[2 * i] : o1[2 * i - 4], ow1 = i < 2 ? o0[2 * i + 1] : o1[2 * i - 3];
              const unsigned r0 = pk2(hv[4 * i] * scl * hw.x * bflo(ow0), hv[4 * i + 1] * scl * hw.y * bfhi(ow0)), r1 = pk2(hv[4 * i + 2] * scl * hw.z * bflo(ow1), hv[4 * i + 3] * scl * hw.w * bfhi(ow1));
              if (i < 2) { w0[2 * i] = r0; w0[2 * i + 1] = r1; } else { w1[2 * i - 4] = r0; w1[2 * i - 3] = r1; } }
          *(u32x4*)(OUTA + tok * D + ch) = w0; *(u32x4*)(OUTA + tok * D + ch + 8) = w1; }
        if (u + G < 2048) ML14_LOAD_O(u + G);
        __syncthreads();
    }
#undef ML14_LOAD
#undef ML14_LOAD_O
}

__global__ void __launch_bounds__(NTHR, 2) trunk_fwd(Args args) {
    extern __shared__ __attribute__((aligned(16))) unsigned char lds_raw[];
    LAS unsigned char* lds = (LAS unsigned char*)lds_raw;
    const int G = gridDim.x, bx = blockIdx.x, vcu = (G % 8 == 0) ? (bx % 8) * (G / 8) + bx / 8 : bx;
    const int NGW = G * NWAVES;
    volatile LAS unsigned* MISC = (volatile LAS unsigned*)(lds + MISC_OFF);
    if (threadIdx.x < 32) MISC[threadIdx.x] = 0u;
    __syncthreads();
    XcdBarrier bar = xcd_barrier_post((unsigned*)(args.ws + WS_CTL), MISC + 8);
#define GRID_BAR() do { xcd_barrier(bar); if (DUP_BAR) xcd_barrier(bar); } while (0)
#define PHASE_BEGIN() int tid = threadIdx.x; asm volatile("" : "+v"(tid)); const int lane = tid & 63, wave = __builtin_amdgcn_readfirstlane(tid >> 6), gw = vcu * NWAVES + wave; (void)gw; (void)lane; \
    GAS unsigned char* ws_g = (GAS unsigned char*)args.ws; asm volatile("" : "+s"(ws_g)); GAS unsigned char* outp_g = (GAS unsigned char*)args.out; asm volatile("" : "+s"(outp_g)); \
    unsigned char* ws = (unsigned char*)ws_g; unsigned char* outp = (unsigned char*)outp_g; \
    float* MOD = (float*)(ws + WS_MOD); const float* MOD1 = MOD + 4 * 6144; (void)MOD1; \
    bf16_t* R1 = (bf16_t*)(ws + WS_R1); bf16_t* R2 = (bf16_t*)(ws + WS_R2); float* XB = (float*)(ws + WS_R2); (void)R1; (void)R2; (void)XB; \
    bf16_t* DO_LO = (bf16_t*)outp; bf16_t* DO_HI = (bf16_t*)(outp + 32 * MiB); (void)DO_LO; (void)DO_HI; \
    LAS float* scr = (LAS float*)(lds + wave * TR_SCR); (void)scr;
    int rot = 0;

    { PHASE_BEGIN();
        ada_phase(args.in[1], args.in[2], args.in[3], MOD, lds, vcu, G, tid, wave, lane);
        bf16_t* Wrkv = (bf16_t*)(ws + WS_WRKV); bf16_t* Wl = (bf16_t*)(ws + WS_WL); bf16_t* Wup = (bf16_t*)(ws + WS_WUP); bf16_t* Wo0 = (bf16_t*)(ws + WS_WO0);
        bf16_t* Wgu0 = (bf16_t*)(ws + WS_WGU0); bf16_t* Wd0 = (bf16_t*)(ws + WS_WD0);
        const float* w_in = args.in[5]; const float* mix = args.in[4];
        tr_job(w_in, 3360, 0, 1024, 1024, 1024, Wrkv, 1024, 0, 0, nullptr, 0, scr, rot, gw, NGW, lane);
        tr_job(w_in, 3360, 1088, 1024, 1024, 1024, Wrkv, 1024, 1024, 0, nullptr, 0, scr, rot, gw, NGW, lane);
        tr_job(w_in, 3360, 2112, 1024, 1024, 1024, Wrkv, 1024, 2048, 0, nullptr, 0, scr, rot, gw, NGW, lane);
        tr_job(w_in, 3360, 1024, 64, 1024, 1024, Wl, 2048, 0, 0, nullptr, 0, scr, rot, gw, NGW, lane);
        tr_job(w_in, 3360, 1024, 64, 1024, 1024, Wl, 2048, 0, 1024, mix + 1 * D, 0, scr, rot, gw, NGW, lane);
        tr_job(w_in, 3360, 3136, 64, 1024, 1024, Wl, 2048, 128, 0, nullptr, 0, scr, rot, gw, NGW, lane);
        tr_job(w_in, 3360, 3136, 64, 1024, 1024, Wl, 2048, 128, 1024, mix + 4 * D, 0, scr, rot, gw, NGW, lane);
        tr_job(w_in, 3360, 3200, 160, 1024, 1024, Wl, 2048, 256, 0, nullptr, 0, scr, rot, gw, NGW, lane);
        tr_job(w_in, 3360, 3200, 160, 1024, 1024, Wl, 2048, 256, 1024, mix + 5 * D, 0, scr, rot, gw, NGW, lane);
        for (int i = gw * 64 + lane; i < (64 + 64 + 96) * 256; i += NGW * 64) { const int r = i >> 8, c16 = i & 255; const int row = r < 64 ? 64 + r : (r < 128 ? 192 + (r - 64) : 416 + (r - 128));
            *(u32x4*)(Wl + (size_t)row * 2048 + 8 * c16) = (u32x4){0u, 0u, 0u, 0u}; }
        tr_job(args.in[7], 1024, 0, 1024, 256, 64, Wup, 256, 0, 0, nullptr, 0, scr, rot, gw, NGW, lane);
        tr_job(args.in[9], 1024, 0, 1024, 256, 64, Wup, 256, 1024, 0, nullptr, 0, scr, rot, gw, NGW, lane);
        tr_job(args.in[10], 1024, 0, 1024, 256, 160, Wup, 256, 2048, 0, nullptr, 0, scr, rot, gw, NGW, lane);
        tr_job(args.in[16], 1024, 0, 1024, 1024, 1024, Wo0, 1024, 0, 0, nullptr, 0, scr, rot, gw, NGW, lane);
        tr_job(args.in[24], 2 * FF, 0, 2 * FF, 1024, 1024, Wgu0, 1024, 0, 0, nullptr, 1, scr, rot, gw, NGW, lane);
        tr_job(args.in[25], 1024, 0, 1024, FF, FF, Wd0, FF, 0, 0, nullptr, 0, scr, rot, gw, NGW, lane);
    }
#if DUP_TR
    __syncthreads();
    { PHASE_BEGIN();
        ada_phase(args.in[1], args.in[2], args.in[3], MOD, lds, vcu, G, tid, wave, lane);
        bf16_t* Wrkv = (bf16_t*)(ws + WS_WRKV); bf16_t* Wl = (bf16_t*)(ws + WS_WL); bf16_t* Wup = (bf16_t*)(ws + WS_WUP); bf16_t* Wo0 = (bf16_t*)(ws + WS_WO0);
        bf16_t* Wgu0 = (bf16_t*)(ws + WS_WGU0); bf16_t* Wd0 = (bf16_t*)(ws + WS_WD0);
        const float* w_in = args.in[5]; const float* mix = args.in[4];
        tr_job(w_in, 3360, 0, 1024, 1024, 1024, Wrkv, 1024, 0, 0, nullptr, 0, scr, rot, gw, NGW, lane);
        tr_job(w_in, 3360, 1088, 1024, 1024, 1024, Wrkv, 1024, 1024, 0, nullptr, 0, scr, rot, gw, NGW, lane);
        tr_job(w_in, 3360, 2112, 1024, 1024, 1024, Wrkv, 1024, 2048, 0, nullptr, 0, scr, rot, gw, NGW, lane);
        tr_job(w_in, 3360, 1024, 64, 1024, 1024, Wl, 2048, 0, 0, nullptr, 0, scr, rot, gw, NGW, lane);
        tr_job(w_in, 3360, 1024, 64, 1024, 1024, Wl, 2048, 0, 1024, mix + 1 * D, 0, scr, rot, gw, NGW, lane);
        tr_job(w_in, 3360, 3136, 64, 1024, 1024, Wl, 2048, 128, 0, nullptr, 0, scr, rot, gw, NGW, lane);
        tr_job(w_in, 3360, 3136, 64, 1024, 1024, Wl, 2048, 128, 1024, mix + 4 * D, 0, scr, rot, gw, NGW, lane);
        tr_job(w_in, 3360, 3200, 160, 1024, 1024, Wl, 2048, 256, 0, nullptr, 0, scr, rot, gw, NGW, lane);
        tr_job(w_in, 3360, 3200, 160, 1024, 1024, Wl, 2048, 256, 1024, mix + 5 * D, 0, scr, rot, gw, NGW, lane);
        for (int i = gw * 64 + lane; i < (64 + 64 + 96) * 256; i += NGW * 64) { const int r = i >> 8, c16 = i & 255; const int row = r < 64 ? 64 + r : (r < 128 ? 192 + (r - 64) : 416 + (r - 128));
            *(u32x4*)(Wl + (size_t)row * 2048 + 8 * c16) = (u32x4){0u, 0u, 0u, 0u}; }
        tr_job(args.in[7], 1024, 0, 1024, 256, 64, Wup, 256, 0, 0, nullptr, 0, scr, rot, gw, NGW, lane);
        tr_job(args.in[9], 1024, 0, 1024, 256, 64, Wup, 256, 1024, 0, nullptr, 0, scr, rot, gw, NGW, lane);
        tr_job(args.in[10], 1024, 0, 1024, 256, 160, Wup, 256, 2048, 0, nullptr, 0, scr, rot, gw, NGW, lane);
        tr_job(args.in[16], 1024, 0, 1024, 1024, 1024, Wo0, 1024, 0, 0, nullptr, 0, scr, rot, gw, NGW, lane);
        tr_job(args.in[24], 2 * FF, 0, 2 * FF, 1024, 1024, Wgu0, 1024, 0, 0, nullptr, 1, scr, rot, gw, NGW, lane);
        tr_job(args.in[25], 1024, 0, 1024, FF, FF, Wd0, FF, 0, 0, nullptr, 0, scr, rot, gw, NGW, lane);
    }
#endif
    cg::this_grid().sync();
    __syncthreads();

    { PHASE_BEGIN(); p1_phase(args.in[0], MOD, args.in[4], R1, DO_LO, gw, NGW, lane); }
#if DUP_NORM
    { PHASE_BEGIN(); p1_phase(args.in[0], MOD, args.in[4], R1, DO_LO, gw, NGW, lane); }
#endif
    GRID_BAR();

    { PHASE_BEGIN();
        pg8::Gemm g2{DO_LO, (bf16_t*)(ws + WS_WL), 2048, 2048, 2048, 0}; pg8::StaticOrder S2; S2.init(T, 512, G, bx);
        pg8::EpiBf16 E2{(bf16_t*)(ws + WS_L), 512, 1};
        pg8::gemm_phase<pg8::EpiBf16, true>(lds, g2, S2, E2);
    }
    { PHASE_BEGIN();
        pg8::Gemm g{R1, (bf16_t*)(ws + WS_WRKV), 1024, 1024, 1024, (size_t)T * D * 2}; pg8::StaticOrder S;
        if (G == 256) { if (bx < 128) S.init_sub(T, 3072, 512, 128, bx, 2); else S.init_sub(T, 3072, 0, 128, bx - 128, 4); } else S.init(T, 3072, G, bx);
        pg8::EpiBf16 E{R2, 3072, 0};
        pg8::gemm_phase<pg8::EpiBf16, true>(lds, g, S, E);
    }
    GRID_BAR();

    { PHASE_BEGIN();
        pg8::Gemm g{(bf16_t*)(ws + WS_L), (bf16_t*)(ws + WS_WUP), 512, 256, 256, (size_t)128 * 2}; pg8::StaticOrder S; S.init(T, 3072, G, bx);
        pg8::EpiUp E{R1, args.in[6], args.in[8]};
        pg8::gemm_phase<pg8::EpiUp, true>(lds, g, S, E);
    }
    GRID_BAR();

    { PHASE_BEGIN(); scan_phase<0>(R2, R1, args.in[11], args.in[12], args.in[13], DO_LO, (float*)(ws + WS_RK), lds, vcu, G, tid, wave, lane); }
    GRID_BAR();
#if DUP_SCAN
    { PHASE_BEGIN(); scan_phase<DUP_SCAN - 1>(R2, R1, args.in[11], args.in[12], args.in[13], DO_HI, (float*)(ws + WS_GATES), lds, vcu, G, tid, wave, lane); }
    GRID_BAR();
#endif

    { PHASE_BEGIN();
        gn_phase(DO_LO, R2, R1, (const float*)(ws + WS_RK), args.in[14], args.in[15], DO_HI, gw, NGW, lane);
        tr_job(args.in[17], 3088, 0, 3072, 1024, 1024, (bf16_t*)(ws + WS_WML), 1024, 0, 0, nullptr, 0, scr, rot, gw, NGW, lane);
        tr_job(args.in[23], 1024, 0, 1024, 1024, 1024, (bf16_t*)(ws + WS_WO1), 1024, 0, 0, nullptr, 0, scr, rot, gw, NGW, lane);
        tr_job(args.in[24] + (size_t)D * 2 * FF, 2 * FF, 0, 2 * FF, 1024, 1024, (bf16_t*)(ws + WS_WGU1), 1024, 0, 0, nullptr, 1, scr, rot, gw, NGW, lane);
        tr_job(args.in[25] + (size_t)FF * D, 1024, 0, 1024, FF, FF, (bf16_t*)(ws + WS_WD1), FF, 0, 0, nullptr, 0, scr, rot, gw, NGW, lane);
    }
    GRID_BAR();

    { PHASE_BEGIN();
        pg8::Gemm g{DO_HI, (bf16_t*)(ws + WS_WO0), 1024, 1024, 1024, 0}; pg8::StaticOrder S; S.init(T, 1024, G, bx);
        pg8::EpiResid E{args.in[0], XB, MOD + 2048};
        pg8::gemm_phase<pg8::EpiResid, true>(lds, g, S, E);
    }
    GRID_BAR();

    { PHASE_BEGIN(); norm_phase(XB, MOD + 3072, MOD + 4096, DO_LO, gw, NGW, lane); }
#if DUP_NORM
    { PHASE_BEGIN(); norm_phase(XB, MOD + 3072, MOD + 4096, DO_LO, gw, NGW, lane); }
#endif
    GRID_BAR();
    { PHASE_BEGIN();
        pg8::Gemm g{DO_LO, (bf16_t*)(ws + WS_WGU0), 1024, 1024, 1024, 0}; pg8::StaticOrder S; S.init(T, 2 * FF, G, bx);
        pg8::EpiSwiglu E{R1};
        pg8::gemm_phase<pg8::EpiSwiglu, true>(lds, g, S, E);
    }
    GRID_BAR();
    { PHASE_BEGIN();
        pg8::Gemm g{R1, (bf16_t*)(ws + WS_WD0), FF, FF, FF, 0}; pg8::StaticOrder S; S.init(T, 1024, G, bx);
        pg8::EpiResid E{XB, XB, MOD + 5120};
        pg8::gemm_phase<pg8::EpiResid, true>(lds, g, S, E);
    }
    GRID_BAR();

    { PHASE_BEGIN(); norm_gates_phase(XB, MOD1, MOD1 + 1024, args.in[17], DO_LO, (float*)(ws + WS_GATES), lds, gw, NGW, tid, lane); }
#if DUP_NORM
    { PHASE_BEGIN(); norm_gates_phase(XB, MOD1, MOD1 + 1024, args.in[17], DO_LO, (float*)(ws + WS_GATES), lds, gw, NGW, tid, lane); }
#endif
    GRID_BAR();
    { PHASE_BEGIN();
        pg8::Gemm g{DO_LO, (bf16_t*)(ws + WS_WML), 1024, 1024, 1024, 0}; pg8::StaticOrder S; S.init(T, 3072, G, bx);
        pg8::EpiBf16 E{R1, 3072, 2};
        pg8::gemm_phase<pg8::EpiBf16, true>(lds, g, S, E);
    }
    GRID_BAR();
    { PHASE_BEGIN();
        ml_local_phase(R1, (const float*)(ws + WS_GATES), args.in[18], args.in[19], args.in[20], args.in[21], (float*)outp, (float*)(ws + WS_NLOC), (float*)(ws + WS_MLOC), (float*)(ws + WS_GTOT), lds, vcu, G, tid, wave, lane);
    }
    GRID_BAR();
    { PHASE_BEGIN();
        ml_scan_phase((const float*)outp, (const float*)(ws + WS_NLOC), (const float*)(ws + WS_MLOC), (const float*)(ws + WS_GTOT), (bf16_t*)(ws + WS_R2 + 64 * MiB), (float*)(ws + WS_NPREV), (float*)(ws + WS_MPREV), vcu, G, tid);
    }
    GRID_BAR();
    { PHASE_BEGIN();
        ml_out_phase(R1, (const float*)(ws + WS_GATES), args.in[18], args.in[19], args.in[20], args.in[21], args.in[22], (const bf16_t*)(ws + WS_R2 + 64 * MiB), (const float*)(ws + WS_NPREV), (const float*)(ws + WS_MPREV), DO_LO, lds, vcu, G, tid, wave, lane);
    }
    GRID_BAR();
#if DUP_ML
    { PHASE_BEGIN();
        ml_local_phase(R1, (const float*)(ws + WS_GATES), args.in[18], args.in[19], args.in[20], args.in[21], (float*)outp, (float*)(ws + WS_NLOC), (float*)(ws + WS_MLOC), (float*)(ws + WS_GTOT), lds, vcu, G, tid, wave, lane);
    }
    GRID_BAR();
    { PHASE_BEGIN();
        ml_scan_phase((const float*)outp, (const float*)(ws + WS_NLOC), (const float*)(ws + WS_MLOC), (const float*)(ws + WS_GTOT), (bf16_t*)(ws + WS_R2 + 64 * MiB), (float*)(ws + WS_NPREV), (float*)(ws + WS_MPREV), vcu, G, tid);
    }
    GRID_BAR();
    { PHASE_BEGIN();
        ml_out_phase(R1, (const float*)(ws + WS_GATES), args.in[18], args.in[19], args.in[20], args.in[21], args.in[22], (const bf16_t*)(ws + WS_R2 + 64 * MiB), (const float*)(ws + WS_NPREV), (const float*)(ws + WS_MPREV), DO_LO, lds, vcu, G, tid, wave, lane);
    }
    GRID_BAR();
#endif
    { PHASE_BEGIN();
        pg8::Gemm g{DO_LO, (bf16_t*)(ws + WS_WO1), 1024, 1024, 1024, 0}; pg8::StaticOrder S; S.init(T, 1024, G, bx);
        pg8::EpiResid E{XB, XB, MOD1 + 2048};
        pg8::gemm_phase<pg8::EpiResid, true>(lds, g, S, E);
    }
    GRID_BAR();
    { PHASE_BEGIN(); norm_phase(XB, MOD1 + 3072, MOD1 + 4096, DO_LO, gw, NGW, lane); }
#if DUP_NORM
    { PHASE_BEGIN(); norm_phase(XB, MOD1 + 3072, MOD1 + 4096, DO_LO, gw, NGW, lane); }
#endif
    GRID_BAR();
    { PHASE_BEGIN();
        pg8::Gemm g{DO_LO, (bf16_t*)(ws + WS_WGU1), 1024, 1024, 1024, 0}; pg8::StaticOrder S; S.init(T, 2 * FF, G, bx);
        pg8::EpiSwiglu E{R1};
        pg8::gemm_phase<pg8::EpiSwiglu, true>(lds, g, S, E);
    }
    GRID_BAR();
    { PHASE_BEGIN();
        pg8::Gemm g{R1, (bf16_t*)(ws + WS_WD1), FF, FF, FF, 0}; pg8::StaticOrder S; S.init(T, 1024, G, bx);
        pg8::EpiResid E{XB, XB, MOD1 + 5120};
        pg8::gemm_phase<pg8::EpiResid, true>(lds, g, S, E);
    }
    GRID_BAR();
    { PHASE_BEGIN(); final_norm_phase(XB, args.in[26], (float*)outp, gw, NGW, lane); }
#if DUP_NORM
    { PHASE_BEGIN(); final_norm_phase(XB, args.in[26], (float*)outp, gw, NGW, lane); }
#endif
}

extern "C" void kernel_launch(void* const* d_in, const int* in_sizes, int n_in, void* d_out, int out_size, void* d_ws, size_t ws_size, hipStream_t stream) {
    static int grid = 0;
    if (grid == 0) {
        if (n_in != 27 || out_size != T * D || ws_size < 256 * MiB) { fprintf(stderr, "kernel_launch: unexpected shapes (n_in %d out %d ws %zu)\n", n_in, out_size, ws_size); grid = -1; return; }
        int dev = 0, cus = 0, per_cu = 0;
        hipGetDevice(&dev); hipDeviceGetAttribute(&cus, hipDeviceAttributeMultiprocessorCount, dev);
        if (hipFuncSetAttribute((const void*)trunk_fwd, hipFuncAttributeMaxDynamicSharedMemorySize, LDS_BYTES) != hipSuccess) { fprintf(stderr, "kernel_launch: hipFuncSetAttribute failed\n"); grid = -1; return; }
        if (hipOccupancyMaxActiveBlocksPerMultiprocessor(&per_cu, (const void*)trunk_fwd, NTHR, LDS_BYTES) != hipSuccess || per_cu < 1) { fprintf(stderr, "kernel_launch: occupancy query says %d\n", per_cu); per_cu = 1; }
        (void)hipGetLastError();
        grid = cus * per_cu;
    }
    if (grid < 0) return;
    hipMemsetAsync((char*)d_ws + WS_CTL, 0, XCD_BAR_WORDS * 4, stream);
    Args a{};
    for (int i = 0; i < 27; ++i) a.in[i] = (const float*)d_in[i];
    a.out = (float*)d_out; a.ws = (unsigned char*)d_ws;
    void* kargs[] = {&a};
    hipError_t e = hipLaunchCooperativeKernel((const void*)trunk_fwd, dim3(grid), dim3(NTHR), kargs, LDS_BYTES, stream);
    if (e != hipSuccess) fprintf(stderr, "cooperative launch failed: %s (grid %d)\n", hipGetErrorString(e), grid);
}
```

```cpp
#include <hip/hip_runtime.h>
#ifndef DUP_SCAN
#define DUP_SCAN 0
#endif
#ifndef DUP_ML
#define DUP_ML 0
#endif
#ifndef DUP_TR
#define DUP_TR 0
#endif
#ifndef DUP_NORM
#define DUP_NORM 0
#endif
#ifndef DUP_BAR
#define DUP_BAR 0
#endif
#include <hip/hip_cooperative_groups.h>
#include <cstdio>
#include <cstdint>
namespace cg = cooperative_groups;

#define LAS __attribute__((address_space(3)))
#define GAS __attribute__((address_space(1)))
typedef unsigned short bf16_t;
typedef short bf16x8 __attribute__((ext_vector_type(8)));
typedef float f32x4 __attribute__((ext_vector_type(4)));
typedef float f32x2 __attribute__((ext_vector_type(2)));
typedef unsigned u32x4 __attribute__((ext_vector_type(4)));
typedef unsigned u32x2 __attribute__((ext_vector_type(2)));

constexpr int T = 16384, D = 1024, SEQ = 4096, FF = 2816, NWAVES = 8, NTHR = 512;
constexpr float EPS = 1e-6f, GN_EPS = 64e-5f;
constexpr size_t MiB = 1u << 20;
constexpr size_t WS_CTL = 255 * MiB;
constexpr size_t WS_WRKV = 0, WS_WL = 6 * MiB, WS_WUP = 8 * MiB, WS_WO0 = 10 * MiB, WS_WGU0 = 12 * MiB, WS_WD0 = 23 * MiB;
constexpr size_t WS_L = 29 * MiB;
constexpr size_t WS_WML = 29 * MiB, WS_WO1 = 35 * MiB, WS_WGU1 = 37 * MiB, WS_WD1 = 48 * MiB;
constexpr size_t WS_MOD = 54 * MiB;
constexpr size_t WS_NLOC = 54 * MiB + 512 * 1024, WS_NPREV = 55 * MiB, WS_MLOC = 55 * MiB + 512 * 1024, WS_GTOT = WS_MLOC + 16384, WS_MPREV = WS_GTOT + 16384;
constexpr size_t WS_RK = 56 * MiB, WS_GATES = 57 * MiB;
constexpr size_t WS_R1 = 58 * MiB, WS_R2 = 154 * MiB;
static_assert(WS_R2 + 96 * MiB <= WS_CTL, "ws map");

__device__ __forceinline__ unsigned f2bf(float f) { unsigned u = __builtin_bit_cast(unsigned, f); return (u + 0x7fffu + ((u >> 16) & 1u)) >> 16; }
__device__ __forceinline__ unsigned pk2(float lo, float hi) { return f2bf(lo) | (f2bf(hi) << 16); }
__device__ __forceinline__ float bflo(unsigned w) { return __builtin_bit_cast(float, w << 16); }
__device__ __forceinline__ float bfhi(unsigned w) { return __builtin_bit_cast(float, w & 0xffff0000u); }
__device__ __forceinline__ float bf2f(bf16_t b) { return __builtin_bit_cast(float, (unsigned)b << 16); }
__device__ __forceinline__ unsigned cvt_pk_bf16(float lo, float hi) { unsigned r; asm volatile("v_cvt_pk_bf16_f32 %0, %1, %2" : "=v"(r) : "v"(lo), "v"(hi)); return r; }
__device__ __forceinline__ float sigmoidf_(float x) { return __builtin_amdgcn_rcpf(1.f + __builtin_amdgcn_exp2f(-1.4426950408889634f * x)); }
__device__ __forceinline__ float siluf_(float x) { return x * __builtin_amdgcn_rcpf(1.f + __builtin_amdgcn_exp2f(-1.4426950408889634f * x)); }
#define LDS_WAIT() asm volatile("s_waitcnt lgkmcnt(0)" ::: "memory")
__device__ __forceinline__ float fma_s(float a, float b, float c) { float r; asm("v_fma_f32 %0, %1, %2, %3" : "=v"(r) : "v"(a), "v"(b), "v"(c)); return r; }
__device__ __forceinline__ float mul_s(float a, float b) { float r; asm("v_mul_f32_e32 %0, %1, %2" : "=v"(r) : "v"(a), "v"(b)); return r; }

template <int CTRL> __device__ __forceinline__ float dpp_mov(float v) { return __builtin_bit_cast(float, __builtin_amdgcn_update_dpp(0, __builtin_bit_cast(int, v), CTRL, 0xf, 0xf, true)); }
__device__ __forceinline__ float red8(float v) { v += dpp_mov<0xB1>(v); v += dpp_mov<0x4E>(v); v += dpp_mov<0x141>(v); return v; }
__device__ __forceinline__ float red16(float v) { v = red8(v); v += dpp_mov<0x140>(v); return v; }
__device__ __forceinline__ float wave_sum(float v) {
#pragma unroll
    for (int o = 1; o < 64; o <<= 1) v += __shfl_xor(v, o);
    return v;
}

namespace pg8 {
constexpr int BM = 256, BK = 64, HALF = 128, HTB = HALF * BK * 2, NXCD = 8, WGM = 8;
__host__ __device__ __forceinline__ int lds_byte(int r, int c) { const int st = (r >> 4) * 2 + (c >> 5), rr = r & 15, cc = c & 31, ob = rr * 64 + cc * 2; return st * 1024 + (ob ^ (((ob >> 9) & 1) << 5)); }
__host__ __device__ __forceinline__ void stage_rc(int b, int& R, int& C) { const int st = b / 1024, sb = b % 1024, swz = sb ^ (((sb >> 9) & 1) << 5); R = (st >> 1) * 16 + swz / 64; C = (st & 1) * 32 + (swz % 64) / 2; }
__host__ __device__ __forceinline__ int perm32(int rho) { const int n = rho >> 4, i = rho & 15; return 8 * (i >> 2) + 4 * n + (i & 3); }
struct Unit { int pm, pn; };
struct Gemm { const bf16_t* A; const bf16_t* Bt; int lda, ldb, K; size_t astep; };
struct StaticOrder {
    int nM, nN, nwg, G, c, cnt;
    __device__ void init(int M, int N, int G_, int c_) { nM = M / BM; nN = N / BM; nwg = nM * nN; G = G_; c = c_; cnt = -1; }
    __device__ void init_sub(int M, int N, int base, int stride, int c_, int cnt_) { nM = M / BM; nN = N / BM; nwg = nM * nN; G = stride; c = base + c_; cnt = cnt_; }
    __device__ bool next(int i, Unit& u) const {
        if (cnt >= 0 && i >= cnt) return false;
        const long L = (long)i * G + c; if (L >= nwg) return false;
        int wgid = (int)L; { const int q = nwg / NXCD, r = nwg % NXCD, xcd = wgid % NXCD, off = wgid / NXCD; wgid = (xcd < r ? xcd * (q + 1) : r * (q + 1) + (xcd - r) * q) + off; }
        const int nig = WGM * nN, gid = wgid / nig, fm = gid * WGM, gsz = (nM - fm) < WGM ? (nM - fm) : WGM;
        u.pm = fm + ((wgid % nig) % gsz); u.pn = (wgid % nig) / gsz; return true;
    }
};

template <class Epi, bool ALIGN_EPI>
__device__ __forceinline__ void gemm_phase(LAS unsigned char* lds, const Gemm g, const StaticOrder& S, const Epi& E) {
    int tid = threadIdx.x; asm volatile("" : "+v"(tid));
    const int wid = __builtin_amdgcn_readfirstlane(tid >> 6), lane = tid & 63, wr = wid >> 2, wc = wid & 3, fr = lane & 15, fq = lane >> 4;
    const int K = g.K, nt = K / BK;
    unsigned voffA[2], voffB[2];
#pragma unroll
    for (int i = 0; i < 2; ++i) { int R, C; stage_rc(tid * 16 + i * 8192, R, C); const int Rb = (R & ~31) + perm32(R & 31);
        voffA[i] = (unsigned)(R * g.lda + C) * 2u; voffB[i] = (unsigned)(Rb * g.ldb + C) * 2u; }
    const size_t kstep = (size_t)(BK * 2);
    const size_t hA = (size_t)HALF * g.lda * 2, hB = (size_t)HALF * g.ldb * 2, tA = 2 * hA, tB = 2 * hB;
    const unsigned ldsw = (unsigned)wid * 1024u;
    const int aoff = lds_byte(wr * 64 + fr, fq * 8), boff = lds_byte(wc * 32 + fr, fq * 8);
#define PG8_SA(b, h) (((b) * 2 + (h)) * HTB)
#define PG8_SB(b, h) ((4 + (b) * 2 + (h)) * HTB)
#define PG8_STAGE(bufoff, gbase, voff) do { _Pragma("unroll") for (int _i = 0; _i < 2; ++_i) \
        __builtin_amdgcn_global_load_lds((const unsigned*)((const char*)(gbase) + (voff)[_i]), (LAS unsigned*)(lds + (bufoff) + ldsw + _i * 8192), 16, 0, 0); } while (0)
#define PG8_LDA(dst, b, h) do { _Pragma("unroll") for (int m = 0; m < 4; ++m) _Pragma("unroll") for (int k = 0; k < 2; ++k) dst[m][k] = *(const LAS bf16x8*)(lds + PG8_SA(b, h) + aoff + m * 2048 + k * 1024); } while (0)
#define PG8_LDB(dst, b, h) do { _Pragma("unroll") for (int n = 0; n < 2; ++n) _Pragma("unroll") for (int k = 0; k < 2; ++k) dst[n][k] = *(const LAS bf16x8*)(lds + PG8_SB(b, h) + boff + n * 2048 + k * 1024); } while (0)
#define PG8_MMA(ai, bj, At, Bt) do { __builtin_amdgcn_s_setprio(1); _Pragma("unroll") for (int m = 0; m < 4; ++m) _Pragma("unroll") for (int n = 0; n < 2; ++n) _Pragma("unroll") for (int k = 0; k < 2; ++k) \
        acc[ai][bj][m][n] = __builtin_amdgcn_mfma_f32_16x16x32_bf16(Bt[n][k], At[m][k], acc[ai][bj][m][n], 0, 0, 0); __builtin_amdgcn_s_setprio(0); } while (0)
#define PG8_WAIT_V(n) asm volatile("s_waitcnt vmcnt(" #n ")" ::: "memory")
#define PG8_WAIT_L(n) asm volatile("s_waitcnt lgkmcnt(" #n ")" ::: "memory")
#define PG8_BAR __builtin_amdgcn_s_barrier()
#define PG8_SCHED __builtin_amdgcn_sched_barrier(0)
    Unit cur, nxt; int ui = 0;
    if (!S.next(0, cur)) return;
    f32x4 acc[2][2][4][2];
#pragma unroll
    for (int a = 0; a < 2; ++a)
#pragma unroll
        for (int b = 0; b < 2; ++b)
#pragma unroll
            for (int m = 0; m < 4; ++m)
#pragma unroll
                for (int n = 0; n < 2; ++n) acc[a][b][m][n] = (f32x4){0.f, 0.f, 0.f, 0.f};
    bf16x8 At[4][2], B0[2][2], B1[2][2];
    const char* cA = (const char*)g.A + (size_t)cur.pm * tA + (size_t)(cur.pn >> 2) * g.astep; const char* cB = (const char*)g.Bt + (size_t)cur.pn * tB;
    PG8_STAGE(PG8_SB(0, 0), cB, voffB); PG8_STAGE(PG8_SB(0, 1), cB + hB, voffB); PG8_STAGE(PG8_SA(0, 0), cA, voffA); PG8_STAGE(PG8_SA(0, 1), cA + hA, voffA);
    if (wr == 1) PG8_BAR;
    PG8_WAIT_V(2); PG8_BAR;
    PG8_STAGE(PG8_SB(1, 0), cB + kstep, voffB); PG8_STAGE(PG8_SA(1, 0), cA + kstep, voffA); PG8_STAGE(PG8_SB(1, 1), cB + hB + kstep, voffB);
    PG8_WAIT_V(6); PG8_BAR;
    for (;;) {
        const bool has_next = S.next(ui + 1, nxt);
        const char* nA = has_next ? (const char*)g.A + (size_t)nxt.pm * tA + (size_t)(nxt.pn >> 2) * g.astep : cA; const char* nB = has_next ? (const char*)g.Bt + (size_t)nxt.pn * tB : cB;
        for (int t = 0; t < nt; t += 2) {
            const bool last = (t == nt - 2);
            const char* a1 = cA + (size_t)(t + 1) * kstep;
            const char* a2 = last ? nA : cA + (size_t)(t + 2) * kstep; const char* b2 = last ? nB : cB + (size_t)(t + 2) * kstep;
            const char* a3 = a2 + kstep; const char* b3 = b2 + kstep;
            PG8_LDB(B0, 0, 0); PG8_LDB(B1, 0, 1); PG8_SCHED; PG8_LDA(At, 0, 0); PG8_STAGE(PG8_SA(1, 1), a1 + hA, voffA);
            PG8_WAIT_V(8); PG8_WAIT_L(0); PG8_BAR; PG8_MMA(0, 0, At, B0); PG8_MMA(0, 1, At, B1); PG8_BAR; PG8_SCHED;
            PG8_LDA(At, 0, 1); PG8_STAGE(PG8_SB(0, 0), b2, voffB); PG8_STAGE(PG8_SB(0, 1), b2 + hB, voffB); PG8_STAGE(PG8_SA(0, 0), a2, voffA);
            PG8_WAIT_V(8); PG8_WAIT_L(0); PG8_BAR; PG8_MMA(1, 0, At, B0); PG8_MMA(1, 1, At, B1); PG8_BAR; PG8_SCHED;
            PG8_LDB(B0, 1, 0); PG8_LDB(B1, 1, 1); PG8_SCHED; PG8_LDA(At, 1, 0); PG8_STAGE(PG8_SA(0, 1), a2 + hA, voffA);
            PG8_WAIT_V(8); PG8_WAIT_L(0); PG8_BAR; PG8_MMA(0, 0, At, B0); PG8_MMA(0, 1, At, B1); PG8_BAR; PG8_SCHED;
            PG8_LDA(At, 1, 1); PG8_STAGE(PG8_SB(1, 0), b3, voffB); PG8_STAGE(PG8_SB(1, 1), b3 + hB, voffB); PG8_STAGE(PG8_SA(1, 0), a3, voffA);
            PG8_WAIT_V(8); PG8_WAIT_L(0); PG8_BAR; PG8_MMA(1, 0, At, B0); PG8_MMA(1, 1, At, B1); PG8_BAR; PG8_SCHED;
        }
        if constexpr (ALIGN_EPI) { if (wr == 0) PG8_BAR; }
        E(acc, cur, wr, wc, fr, fq);
        if (!has_next) break;
#pragma unroll
        for (int a = 0; a < 2; ++a)
#pragma unroll
            for (int b = 0; b < 2; ++b)
#pragma unroll
                for (int m = 0; m < 4; ++m)
#pragma unroll
                    for (int n = 0; n < 2; ++n) acc[a][b][m][n] = (f32x4){0.f, 0.f, 0.f, 0.f};
        cur = nxt; cA = nA; cB = nB; ++ui;
        if constexpr (ALIGN_EPI) { if (wr == 1) PG8_BAR; }
    }
    PG8_WAIT_V(0);
    if constexpr (!ALIGN_EPI) { if (wr == 0) PG8_BAR; }
    PG8_BAR;
#undef PG8_SA
#undef PG8_SB
#undef PG8_STAGE
#undef PG8_LDA
#undef PG8_LDB
#undef PG8_MMA
#undef PG8_WAIT_V
#undef PG8_WAIT_L
#undef PG8_BAR
#undef PG8_SCHED
}

typedef f32x4 Acc[2][2][4][2];
struct EpiBf16 {
    bf16_t* O; int ldc; int mode;
    __device__ __forceinline__ void operator()(const Acc& acc, const Unit& u, int wr, int wc, int fr, int fq) const {
        const int row0 = u.pm * BM + wr * 64 + fr, col0 = u.pn * BM + wc * 32 + 8 * fq;
#pragma unroll
        for (int ai = 0; ai < 2; ++ai)
#pragma unroll
            for (int m = 0; m < 4; ++m) { bf16_t* rowp = O + (size_t)(row0 + ai * HALF + m * 16) * ldc + col0;
#pragma unroll
                for (int bj = 0; bj < 2; ++bj) { f32x4 v0 = acc[ai][bj][m][0], v1 = acc[ai][bj][m][1];
                    int act = 0; if (mode == 1) act = (u.pn == 0) ? (bj == 0 ? 1 : 0) : 2; else if (mode == 2) act = (u.pn >= 8) ? 2 : 0;
                    if (act == 1) {
#pragma unroll
                        for (int i = 0; i < 4; ++i) { v0[i] = tanhf(v0[i]); v1[i] = tanhf(v1[i]); } }
                    else if (act == 2) {
#pragma unroll
                        for (int i = 0; i < 4; ++i) { v0[i] = sigmoidf_(v0[i]); v1[i] = sigmoidf_(v1[i]); } }
                    u32x4 w; w.x = cvt_pk_bf16(v0[0], v0[1]); w.y = cvt_pk_bf16(v0[2], v0[3]); w.z = cvt_pk_bf16(v1[0], v1[1]); w.w = cvt_pk_bf16(v1[2], v1[3]);
                    *(u32x4*)(rowp + bj * HALF) = w; } }
    }
};
struct EpiUp {
    bf16_t* O; const float* w0; const float* a0;
    __device__ __forceinline__ void operator()(const Acc& acc, const Unit& u, int wr, int wc, int fr, int fq) const {
        const int grp = u.pn >> 2;
        const int row0 = u.pm * BM + wr * 64 + fr, col0 = u.pn * BM + wc * 32 + 8 * fq, cc0 = col0 - grp * 1024;
        const float* bp = (grp == 0 ? w0 : a0) + cc0;
#pragma unroll
        for (int bj = 0; bj < 2; ++bj) {
            f32x4 b0 = (f32x4){0.f, 0.f, 0.f, 0.f}, b1 = b0;
            if (grp < 2) { b0 = *(const f32x4*)(bp + bj * HALF); b1 = *(const f32x4*)(bp + bj * HALF + 4); }
#pragma unroll
            for (int ai = 0; ai < 2; ++ai)
#pragma unroll
                for (int m = 0; m < 4; ++m) { bf16_t* rowp = O + (size_t)(row0 + ai * HALF + m * 16) * 3072 + col0;
                    f32x4 v0 = acc[ai][bj][m][0] + b0, v1 = acc[ai][bj][m][1] + b1;
                    if (grp == 0) {
#pragma unroll
                        for (int i = 0; i < 4; ++i) { v0[i] = -0.60653066f * sigmoidf_(v0[i]); v1[i] = -0.60653066f * sigmoidf_(v1[i]); } }
                    else if (grp == 1) {
#pragma unroll
                        for (int i = 0; i < 4; ++i) { v0[i] = sigmoidf_(v0[i]); v1[i] = sigmoidf_(v1[i]); } }
                    u32x4 w; w.x = cvt_pk_bf16(v0[0], v0[1]); w.y = cvt_pk_bf16(v0[2], v0[3]); w.z = cvt_pk_bf16(v1[0], v1[1]); w.w = cvt_pk_bf16(v1[2], v1[3]);
                    *(u32x4*)(rowp + bj * HALF) = w; }
        }
    }
};
struct EpiResid {
    const float* Xin; float* Xout; const float* gate;
    __device__ __forceinline__ void operator()(const Acc& acc, const Unit& u, int wr, int wc, int fr, int fq) const {
        const int row0 = u.pm * BM + wr * 64 + fr, col0 = u.pn * BM + wc * 32 + 8 * fq;
        const float* gp = gate + (size_t)((u.pm * BM) / SEQ) * 6144 + col0;
#pragma unroll
        for (int bj = 0; bj < 2; ++bj) {
            const f32x4 g0 = *(const f32x4*)(gp + bj * HALF), g1 = *(const f32x4*)(gp + bj * HALF + 4);
#pragma unroll
            for (int ai = 0; ai < 2; ++ai)
#pragma unroll
                for (int m = 0; m < 4; ++m) { const size_t ro = (size_t)(row0 + ai * HALF + m * 16) * D + col0 + bj * HALF;
                    const f32x4 x0 = *(const f32x4*)(Xin + ro), x1 = *(const f32x4*)(Xin + ro + 4);
                    *(f32x4*)(Xout + ro) = x0 + g0 * acc[ai][bj][m][0]; *(f32x4*)(Xout + ro + 4) = x1 + g1 * acc[ai][bj][m][1]; }
        }
    }
};
struct EpiSwiglu {
    bf16_t* O;
    __device__ __forceinline__ void operator()(const Acc& acc, const Unit& u, int wr, int wc, int fr, int fq) const {
        const int row0 = u.pm * BM + wr * 64 + fr, col0 = u.pn * HALF + wc * 32 + 8 * fq;
#pragma unroll
        for (int ai = 0; ai < 2; ++ai)
#pragma unroll
            for (int m = 0; m < 4; ++m) { f32x4 v[2];
#pragma unroll
                for (int n = 0; n < 2; ++n)
#pragma unroll
                    for (int i = 0; i < 4; ++i) { const float gt = acc[ai][0][m][n][i]; v[n][i] = siluf_(gt) * acc[ai][1][m][n][i]; }
                u32x4 w; w.x = cvt_pk_bf16(v[0][0], v[0][1]); w.y = cvt_pk_bf16(v[0][2], v[0][3]); w.z = cvt_pk_bf16(v[1][0], v[1][1]); w.w = cvt_pk_bf16(v[1][2], v[1][3]);
                *(u32x4*)(O + (size_t)(row0 + ai * HALF + m * 16) * FF + col0) = w; }
    }
};
}

#define XB_TMO      128
#define XB_XCNT(j)  (256  + 64 * (j))
#define XB_XSUB(j)  (1280 + 64 * (j))
#define XB_XGEN(j)  (2304 + 64 * (j))
#define XB_TOP      3328
#define XB_TOPGEN   3392
#define XCD_BAR_WORDS 3456
#define XB_SPIN_CAP (1u << 20)
__device__ __forceinline__ unsigned xb_ld(unsigned* p)              { return __hip_atomic_load(p, __ATOMIC_RELAXED, __HIP_MEMORY_SCOPE_AGENT); }
__device__ __forceinline__ unsigned xb_add(unsigned* p, unsigned v) { return __hip_atomic_fetch_add(p, v, __ATOMIC_RELAXED, __HIP_MEMORY_SCOPE_AGENT); }
__device__ __forceinline__ unsigned xb_xcc_id() { return (unsigned)__builtin_amdgcn_s_getreg((3 << 11) | 20) & 0xFu; }
#define XB_SPIN(cond, bar) do { unsigned _sp = 0; while (cond) { __builtin_amdgcn_s_sleep(1); \
    if ((++_sp & 255u) == 0u) { if (xb_ld(&(bar)[XB_TMO])) break; if (_sp > XB_SPIN_CAP) { atomicAdd(&(bar)[XB_TMO], 1u); break; } } } } while (0)
struct XcdBarrier { unsigned* bar; unsigned x; volatile LAS unsigned* st; };
__device__ __forceinline__ XcdBarrier xcd_barrier_post(unsigned* bar, volatile LAS unsigned* st) {
    XcdBarrier b; b.bar = bar; b.x = xb_xcc_id(); b.st = st;
    if (threadIdx.x == 0) (void)xb_add(&bar[XB_XCNT(b.x)], 1u);
    return b;
}
__device__ __forceinline__ void xcd_barrier_complete(unsigned* bar, unsigned x, unsigned& nloc, unsigned& nx) {
    const unsigned G = gridDim.x * gridDim.y * gridDim.z;
    unsigned sum, cnt, mine, sp = 0u;
    for (;;) {
        sum = 0u; cnt = 0u; mine = 0u;
#pragma unroll
        for (unsigned j = 0; j < 16; ++j) { const unsigned c = xb_ld(&bar[XB_XCNT(j)]); sum += c; cnt += (c > 0u) ? 1u : 0u; mine = (j == x) ? c : mine; }
        if (sum == G) break;
        __builtin_amdgcn_s_sleep(1);
        if ((++sp & 255u) == 0u) { if (xb_ld(&bar[XB_TMO])) break; if (sp > XB_SPIN_CAP) { atomicAdd(&bar[XB_TMO], 1u); break; } }
    }
    nloc = mine > 0u ? mine : 1u; nx = cnt > 0u ? cnt : 1u;
}
__device__ __forceinline__ void xcd_barrier(const XcdBarrier& b) {
    asm volatile("s_waitcnt vmcnt(0)" ::: "memory");
    __syncthreads();
    if (threadIdx.x == 0) {
        unsigned* bar = b.bar;
        __builtin_amdgcn_s_waitcnt(0);
        unsigned nloc = b.st[0], nx = b.st[1];
        if (nloc == 0u) { xcd_barrier_complete(bar, b.x, nloc, nx); b.st[0] = nloc; b.st[1] = nx; }
        const unsigned old = xb_add(&bar[XB_XSUB(b.x)], 1u);
        const unsigned gen = old / nloc;
        if (old + 1u == (gen + 1u) * nloc) {
            __builtin_amdgcn_fence(__ATOMIC_RELEASE, "agent");
            asm volatile("s_waitcnt vmcnt(0)" ::: "memory");
            const unsigned og = xb_add(&bar[XB_TOP], 1u);
            const unsigned tg = og / nx;
            if (og + 1u == (tg + 1u) * nx) xb_add(&bar[XB_TOPGEN], 1u);
            else XB_SPIN(xb_ld(&bar[XB_TOPGEN]) == tg, bar);
            __builtin_amdgcn_fence(__ATOMIC_ACQUIRE, "agent");
            xb_add(&bar[XB_XGEN(b.x)], 1u);
            asm volatile("s_waitcnt vmcnt(0)" ::: "memory");
        } else {
            XB_SPIN(xb_ld(&bar[XB_XGEN(b.x)]) == gen, bar);
            __builtin_amdgcn_fence(__ATOMIC_ACQUIRE, "agent");
            asm volatile("s_waitcnt vmcnt(0)" ::: "memory");
        }
    }
    __syncthreads();
}

constexpr int RING_BYTES = 131072, MISC_OFF = 151808 + 64, LDS_BYTES = 152576;

constexpr int TR_SCR = 64 * 68 * 4;
__device__ __forceinline__ void tr_job(const float* W, int ldw, int col0, int ncols, int Kp, int kmax, bf16_t* WT, int ldt, int drow0, int dk0, const float* ks, int gu,
                                       LAS float* scr, int& rot, int gw, int NGW, int lane) {
    const int nblk = (ncols + 63) / 64, nitems = (Kp / 64) * nblk;
    int start = gw - rot; if (start < 0) start += NGW;
    for (int it = start; it < nitems; it += NGW) {
        const int kb = it / nblk, nb = it % nblk, k0 = 64 * kb, n0 = 64 * nb, nvalid = (ncols - n0) < 64 ? (ncols - n0) : 64;
        const int n4 = (lane & 15) * 4, kq = lane >> 4;
#pragma unroll 8
        for (int i = 0; i < 16; ++i) { const int kk = 4 * i + kq, k = k0 + kk; f32x4 v = (f32x4){0.f, 0.f, 0.f, 0.f};
            if (k < kmax && n4 < nvalid) { v = *(const f32x4*)(W + (size_t)k * ldw + col0 + n0 + n4); if (ks) v = v * ks[k]; }
            *(LAS f32x4*)(scr + kk * 68 + n4) = v; }
        LDS_WAIT(); asm volatile("" ::: "memory");
        int drow = drow0 + n0;
        if (gu) { int j0 = n0; if (j0 < FF) drow = 256 * (j0 / 128) + (j0 % 128); else { j0 -= FF; drow = 256 * (j0 / 128) + 128 + (j0 % 128); } }
        const int c = lane & 7;
#pragma unroll
        for (int j = 0; j < 8; ++j) { const int n = (lane >> 3) + 8 * j; const LAS float* sp = scr + (8 * c) * 68 + n;
            u32x4 o; o.x = pk2(sp[0 * 68], sp[1 * 68]); o.y = pk2(sp[2 * 68], sp[3 * 68]); o.z = pk2(sp[4 * 68], sp[5 * 68]); o.w = pk2(sp[6 * 68], sp[7 * 68]);
            if (n < nvalid) *(u32x4*)(WT + (size_t)(drow + n) * ldt + dk0 + k0 + 8 * c) = o; }
        LDS_WAIT(); asm volatile("" ::: "memory");
    }
    rot = (rot + nitems) % NGW;
}

struct Args { const float* in[27]; float* out; unsigned char* ws; };

__device__ __forceinline__ void ada_phase(const float* c, const float* ada_w, const float* ada_b, float* MOD, LAS unsigned char* lds, int vcu, int G, int tid, int wave, int lane) {
    LAS float* cact = (LAS float*)lds;
    LAS float* part = (LAS float*)(lds + 16384);
    bool have = false;
    for (int item = vcu; item < 192; item += G) {
        if (!have) { for (int i = tid; i < 4096; i += NTHR) { const float v = c[i]; cact[i] = v / (1.f + expf(-v)); } __syncthreads(); have = true; }
        const int l = item / 96, cb = item % 96;
        const int r4 = lane >> 4, c4 = (lane & 15) * 4;
        const float* Wp = ada_w + (size_t)l * D * 6144 + cb * 64 + c4;
        f32x4 a0 = (f32x4){0.f, 0.f, 0.f, 0.f}, a1 = a0, a2 = a0, a3 = a0;
#pragma unroll 8
        for (int kk = 0; kk < 32; ++kk) { const int k = wave * 128 + 4 * kk + r4; const f32x4 w = *(const f32x4*)(Wp + (size_t)k * 6144);
            a0 += w * cact[k]; a1 += w * cact[1024 + k]; a2 += w * cact[2048 + k]; a3 += w * cact[3072 + k]; }
#pragma unroll
        for (int i = 0; i < 4; ++i) { a0[i] += __shfl_xor(a0[i], 16); a0[i] += __shfl_xor(a0[i], 32); a1[i] += __shfl_xor(a1[i], 16); a1[i] += __shfl_xor(a1[i], 32);
                                      a2[i] += __shfl_xor(a2[i], 16); a2[i] += __shfl_xor(a2[i], 32); a3[i] += __shfl_xor(a3[i], 16); a3[i] += __shfl_xor(a3[i], 32); }
        if (r4 == 0) { *(LAS f32x4*)(part + (wave * 4 + 0) * 64 + c4) = a0; *(LAS f32x4*)(part + (wave * 4 + 1) * 64 + c4) = a1; *(LAS f32x4*)(part + (wave * 4 + 2) * 64 + c4) = a2; *(LAS f32x4*)(part + (wave * 4 + 3) * 64 + c4) = a3; }
        __syncthreads();
        if (tid < 256) { const int b = tid >> 6, cc = tid & 63; float s = 0.f;
#pragma unroll
            for (int w = 0; w < 8; ++w) s += part[(w * 4 + b) * 64 + cc];
            MOD[(size_t)(l * 4 + b) * 6144 + cb * 64 + cc] = s + ada_b[l * 6144 + cb * 64 + cc]; }
        __syncthreads();
    }
}

#define RCOL(j) (512 * ((j) >> 1) + 8 * lane + 4 * ((j) & 1))
__device__ __forceinline__ void st_bf16x8(bf16_t* p, f32x4 a, f32x4 b) { u32x4 w; w.x = pk2(a.x, a.y); w.y = pk2(a.z, a.w); w.z = pk2(b.x, b.y); w.w = pk2(b.z, b.w); *(u32x4*)p = w; }
__device__ __forceinline__ void rms_mod_row(const float* xrow, const float* sc, const float* sh, int lane, f32x4 (&h)[4]) {
    float ss = 0.f;
#pragma unroll
    for (int j = 0; j < 4; ++j) { h[j] = *(const f32x4*)(xrow + RCOL(j)); ss += (h[j].x * h[j].x + h[j].y * h[j].y) + (h[j].z * h[j].z + h[j].w * h[j].w); }
    const float rstd = 1.f / sqrtf(wave_sum(ss) * (1.f / D) + EPS);
#pragma unroll
    for (int j = 0; j < 4; ++j) { const f32x4 a = *(const f32x4*)(sc + RCOL(j)), b = *(const f32x4*)(sh + RCOL(j)); h[j] = h[j] * rstd * (a + 1.f) + b; }
}
__device__ __forceinline__ void st_bf16x4(bf16_t* p, f32x4 v) { u32x2 w; w.x = pk2(v.x, v.y); w.y = pk2(v.z, v.w); *(u32x2*)p = w; }

__device__ __forceinline__ void p1_phase(const float* x, const float* MOD0, const float* mix, bf16_t* XS, bf16_t* HX, int gw, int NGW, int lane) {
    for (int ch = gw; ch < T / 8; ch += NGW) {
        const int row0 = ch * 8, b = row0 / SEQ, has_prev = (row0 % SEQ) != 0, nrows = 8 + has_prev;
        const float* sh = MOD0 + (size_t)b * 6144; const float* sc = sh + 1024;
        const float* base = x + (size_t)(row0 - has_prev) * D;
        f32x4 hp[4], h[4], cur[4], nxt[4];
#pragma unroll
        for (int j = 0; j < 4; ++j) { hp[j] = (f32x4){0.f, 0.f, 0.f, 0.f}; cur[j] = *(const f32x4*)(base + RCOL(j)); nxt[j] = cur[j]; }
        for (int i = 0; i < nrows; ++i) {
            if (i + 1 < nrows) {
#pragma unroll
                for (int j = 0; j < 4; ++j) nxt[j] = *(const f32x4*)(base + (size_t)(i + 1) * D + RCOL(j)); }
            float ss = 0.f;
#pragma unroll
            for (int j = 0; j < 4; ++j) ss += (cur[j].x * cur[j].x + cur[j].y * cur[j].y) + (cur[j].z * cur[j].z + cur[j].w * cur[j].w);
            const float rstd = 1.f / sqrtf(wave_sum(ss) * (1.f / D) + EPS);
            const size_t row = (size_t)(row0 - has_prev + i);
#pragma unroll
            for (int j = 0; j < 4; ++j) { const int col = RCOL(j); const f32x4 a = *(const f32x4*)(sc + col), bb = *(const f32x4*)(sh + col); h[j] = cur[j] * rstd * (a + 1.f) + bb; }
            if (i >= has_prev) {
#pragma unroll
                for (int jp = 0; jp < 4; jp += 2) { const int col = RCOL(jp); f32x4 xx[2], o[2];
#pragma unroll
                    for (int e = 0; e < 2; ++e) xx[e] = hp[jp + e] - h[jp + e];
#pragma unroll
                    for (int e = 0; e < 2; ++e) o[e] = h[jp + e] + xx[e] * *(const f32x4*)(mix + col + 4 * e);
                    st_bf16x8(XS + row * D + col, o[0], o[1]);
#pragma unroll
                    for (int e = 0; e < 2; ++e) o[e] = h[jp + e] + xx[e] * *(const f32x4*)(mix + 2 * D + col + 4 * e);
                    st_bf16x8(XS + (size_t)T * D + row * D + col, o[0], o[1]);
#pragma unroll
                    for (int e = 0; e < 2; ++e) o[e] = h[jp + e] + xx[e] * *(const f32x4*)(mix + 3 * D + col + 4 * e);
                    st_bf16x8(XS + (size_t)2 * T * D + row * D + col, o[0], o[1]);
                    st_bf16x8(HX + row * 2048 + col, h[jp], h[jp + 1]);
                    st_bf16x8(HX + row * 2048 + 1024 + col, xx[0], xx[1]); } }
#pragma unroll
            for (int j = 0; j < 4; ++j) { hp[j] = h[j]; cur[j] = nxt[j]; }
        }
    }
}
__device__ __forceinline__ void norm_phase(const float* X, const float* sh, const float* sc, bf16_t* H, int gw, int NGW, int lane) {
    for (int row0 = gw * 4; row0 < T; row0 += NGW * 4) {
        const int b = row0 / SEQ; f32x4 h[4][4]; float ss[4];
#pragma unroll
        for (int r = 0; r < 4; ++r) { ss[r] = 0.f;
#pragma unroll
            for (int j = 0; j < 4; ++j) h[r][j] = *(const f32x4*)(X + (size_t)(row0 + r) * D + RCOL(j)); }
#pragma unroll
        for (int r = 0; r < 4; ++r)
#pragma unroll
            for (int j = 0; j < 4; ++j) ss[r] += (h[r][j].x * h[r][j].x + h[r][j].y * h[r][j].y) + (h[r][j].z * h[r][j].z + h[r][j].w * h[r][j].w);
#pragma unroll
        for (int o = 1; o < 64; o <<= 1) {
#pragma unroll
            for (int r = 0; r < 4; ++r) ss[r] += __shfl_xor(ss[r], o); }
#pragma unroll
        for (int jp = 0; jp < 4; jp += 2) { const f32x4 a0 = *(const f32x4*)(sc + (size_t)b * 6144 + RCOL(jp)) + 1.f, b0 = *(const f32x4*)(sh + (size_t)b * 6144 + RCOL(jp)),
                                                       a1 = *(const f32x4*)(sc + (size_t)b * 6144 + RCOL(jp + 1)) + 1.f, b1 = *(const f32x4*)(sh + (size_t)b * 6144 + RCOL(jp + 1));
#pragma unroll
            for (int r = 0; r < 4; ++r) { const float rstd = 1.f / sqrtf(ss[r] * (1.f / D) + EPS); st_bf16x8(H + (size_t)(row0 + r) * D + RCOL(jp), h[r][jp] * rstd * a0 + b0, h[r][jp + 1] * rstd * a1 + b1); } }
    }
}
__device__ __forceinline__ void norm_gates_phase(const float* X, const float* sh, const float* sc, const float* w_in, bf16_t* H, float* GATES, LAS unsigned char* lds, int gw, int NGW, int tid, int lane) {
    LAS float* wg = (LAS float*)lds;
    for (int i = tid; i < 1024 * 16; i += NTHR) wg[i] = w_in[(size_t)(i >> 4) * 3088 + 3072 + (i & 15)];
    __syncthreads();
    for (int row = gw; row < T; row += NGW) {
        const int b = row / SEQ; f32x4 h[4];
        rms_mod_row(X + (size_t)row * D, sc + (size_t)b * 6144, sh + (size_t)b * 6144, lane, h);
        asm volatile("" ::: "memory");
        float g[16];
#pragma unroll
        for (int i = 0; i < 16; ++i) g[i] = 0.f;
#pragma unroll
        for (int j = 0; j < 4; ++j) { if ((j & 1) == 0) st_bf16x8(H + (size_t)row * D + RCOL(j), h[j], h[j + 1]);
#pragma unroll
            for (int e = 0; e < 4; ++e) { const LAS f32x4* wp = (const LAS f32x4*)(wg + (RCOL(j) + e) * 16); const float hv = h[j][e];
#pragma unroll
                for (int q = 0; q < 4; ++q) { const f32x4 w = wp[q]; g[4 * q] += hv * w.x; g[4 * q + 1] += hv * w.y; g[4 * q + 2] += hv * w.z; g[4 * q + 3] += hv * w.w; } } }
#pragma unroll
        for (int i = 0; i < 16; ++i) { float v = red16(g[i]);
            v += __builtin_bit_cast(float, __builtin_amdgcn_update_dpp(0, __builtin_bit_cast(int, v), 0x142, 0xa, 0xf, false));
            v += __builtin_bit_cast(float, __builtin_amdgcn_update_dpp(0, __builtin_bit_cast(int, v), 0x143, 0xc, 0xf, false));
            g[i] = v; }
        if (lane == 63) {
#pragma unroll
            for (int q = 0; q < 4; ++q) *(f32x4*)(GATES + (size_t)row * 16 + 4 * q) = (f32x4){g[4 * q], g[4 * q + 1], g[4 * q + 2], g[4 * q + 3]}; }
    }
    __syncthreads();
}
__device__ __forceinline__ void final_norm_phase(const float* X, const float* fw, float* out, int gw, int NGW, int lane) {
    for (int row0 = gw * 4; row0 < T; row0 += NGW * 4) {
        f32x4 h[4][4]; float ss[4];
#pragma unroll
        for (int r = 0; r < 4; ++r) { ss[r] = 0.f;
#pragma unroll
            for (int j = 0; j < 4; ++j) h[r][j] = *(const f32x4*)(X + (size_t)(row0 + r) * D + RCOL(j)); }
#pragma unroll
        for (int r = 0; r < 4; ++r)
#pragma unroll
            for (int j = 0; j < 4; ++j) ss[r] += (h[r][j].x * h[r][j].x + h[r][j].y * h[r][j].y) + (h[r][j].z * h[r][j].z + h[r][j].w * h[r][j].w);
#pragma unroll
        for (int o = 1; o < 64; o <<= 1) {
#pragma unroll
            for (int r = 0; r < 4; ++r) ss[r] += __shfl_xor(ss[r], o); }
#pragma unroll
        for (int j = 0; j < 4; ++j) { const f32x4 w = *(const f32x4*)(fw + RCOL(j));
#pragma unroll
            for (int r = 0; r < 4; ++r) { const float rstd = 1.f / sqrtf(ss[r] * (1.f / D) + EPS); *(f32x4*)(out + (size_t)(row0 + r) * D + RCOL(j)) = h[r][j] * rstd * w; } }
    }
}

constexpr int TC = 32;
constexpr int SC_BUF = 5 * TC * 64 * 4 + TC * 16 * 4 + TC * 256 * 4 + (TC / 2) * 8;
static_assert(2 * SC_BUF <= 151808 && MISC_OFF + 128 <= LDS_BYTES, "scan LDS");
#define SC_BAR() do { asm volatile("s_waitcnt lgkmcnt(0)" ::: "memory"); __builtin_amdgcn_s_barrier(); asm volatile("" ::: "memory"); } while (0)
template <int MODE>
__device__ __forceinline__ void scan_phase(const bf16_t* RKV, const bf16_t* WAG, const float* k_k, const float* k_a, const float* r_k, bf16_t* Y, float* RK, LAS unsigned char* lds, int vcu, int G, int tid, int wave, int lane) {
    for (int item = vcu; item < 256; item += G) {
        const int bh = item >> 2, q = item & 3, b = bh >> 4, h = bh & 15;
        const size_t tok0 = (size_t)b * SEQ;
        if (wave >= 4) {
            const int p = tid - 256, tt = p >> 3, c8 = p & 7, ch = h * 64 + 8 * c8;
            float kkp[8], kap[8], rkp[8];
#pragma unroll
            for (int i = 0; i < 8; ++i) { kkp[i] = k_k[ch + i]; kap[i] = k_a[ch + i]; rkp[i] = r_k[ch + i]; }
            u32x4 lr0, lk0, ld0, la0, lv0 = (u32x4){0u, 0u, 0u, 0u}, lr1, lk1, ld1, la1, lv1 = (u32x4){0u, 0u, 0u, 0u};
            const int vt = p >> 1, vh = p & 1;
#define SC_LOAD(S, chunk) do { const size_t tk = tok0 + (size_t)(chunk) * TC + tt; \
                lr##S = *(const u32x4*)(RKV + tk * 3072 + ch); lk##S = *(const u32x4*)(RKV + tk * 3072 + 1024 + ch); \
                ld##S = *(const u32x4*)(WAG + tk * 3072 + ch); la##S = *(const u32x4*)(WAG + tk * 3072 + 1024 + ch); \
                if (p < 64) lv##S = *(const u32x4*)(RKV + (tok0 + (size_t)(chunk) * TC + vt) * 3072 + 2048 + h * 64 + 16 * q + 8 * vh); } while (0)
#define SC_PREP(S, chunk, bufi) do { LAS float* B_ = (LAS float*)(lds + (bufi) * SC_BUF); \
                float r[8], k[8], dl[8], a[8]; \
                _Pragma("unroll") for (int i = 0; i < 4; ++i) { r[2*i] = bflo(lr##S[i]); r[2*i+1] = bfhi(lr##S[i]); k[2*i] = bflo(lk##S[i]); k[2*i+1] = bfhi(lk##S[i]); \
                    dl[2*i] = bflo(ld##S[i]); dl[2*i+1] = bfhi(ld##S[i]); a[2*i] = bflo(la##S[i]); a[2*i+1] = bfhi(la##S[i]); } \
                float ss = 0.f, rk = 0.f, kq[8], k2[8]; \
                _Pragma("unroll") for (int i = 0; i < 8; ++i) { kq[i] = k[i] * kkp[i]; ss += kq[i] * kq[i]; k2[i] = k[i] * (1.f + (a[i] - 1.f) * kap[i]); rk += r[i] * k2[i] * rkp[i]; } \
                ss = red8(ss); rk = red8(rk); \
                const float inv = __builtin_amdgcn_rcpf(fmaxf(__builtin_amdgcn_sqrtf(ss), 1e-12f)); \
                f32x4 o0, o1; \
                o0 = (f32x4){r[0], r[1], r[2], r[3]}; o1 = (f32x4){r[4], r[5], r[6], r[7]}; *(LAS f32x4*)(B_ + 0 * TC * 64 + tt * 64 + 8 * c8) = o0; *(LAS f32x4*)(B_ + 0 * TC * 64 + tt * 64 + 8 * c8 + 4) = o1; \
                float wv[8], at[8], bt[8], atp[8], mpart = 0.f, npart = 0.f; \
                _Pragma("unroll") for (int i = 0; i < 8; ++i) { wv[i] = __expf(dl[i]); at[i] = -kq[i] * inv; bt[i] = kq[i] * inv * a[i]; } \
                  \
                _Pragma("unroll") for (int i = 0; i < 8; ++i) { const float wp = dpp_mov<0x118>(wv[i]), bp = dpp_mov<0x118>(bt[i]), kp = dpp_mov<0x118>(k2[i]); \
                    atp[i] = (tt & 1) ? at[i] * wp : at[i]; mpart += bp * at[i]; npart += kp * at[i]; } \
                mpart = red8(mpart); npart = red8(npart); \
                if ((tt & 1) && c8 == 0) *(LAS f32x2*)(B_ + 5 * TC * 64 + TC * 16 + TC * 256 + (tt >> 1) * 2) = (f32x2){mpart, npart}; \
                o0 = (f32x4){wv[0], wv[1], wv[2], wv[3]}; o1 = (f32x4){wv[4], wv[5], wv[6], wv[7]}; *(LAS f32x4*)(B_ + 1 * TC * 64 + tt * 64 + 8 * c8) = o0; *(LAS f32x4*)(B_ + 1 * TC * 64 + tt * 64 + 8 * c8 + 4) = o1; \
                o0 = (f32x4){k2[0], k2[1], k2[2], k2[3]}; o1 = (f32x4){k2[4], k2[5], k2[6], k2[7]}; *(LAS f32x4*)(B_ + 2 * TC * 64 + tt * 64 + 8 * c8) = o0; *(LAS f32x4*)(B_ + 2 * TC * 64 + tt * 64 + 8 * c8 + 4) = o1; \
                o0 = (f32x4){atp[0], atp[1], atp[2], atp[3]}; o1 = (f32x4){atp[4], atp[5], atp[6], atp[7]}; *(LAS f32x4*)(B_ + 3 * TC * 64 + tt * 64 + 8 * c8) = o0; *(LAS f32x4*)(B_ + 3 * TC * 64 + tt * 64 + 8 * c8 + 4) = o1; \
                o0 = (f32x4){bt[0], bt[1], bt[2], bt[3]}; o1 = (f32x4){bt[4], bt[5], bt[6], bt[7]}; *(LAS f32x4*)(B_ + 4 * TC * 64 + tt * 64 + 8 * c8) = o0; *(LAS f32x4*)(B_ + 4 * TC * 64 + tt * 64 + 8 * c8 + 4) = o1; \
                if (p < 64) { LAS float* V_ = B_ + 5 * TC * 64 + (vt >> 1) * 32 + (8 * vh) * 2 + (vt & 1);     \
                    _Pragma("unroll") for (int i = 0; i < 4; ++i) { V_[(2 * i) * 2] = bflo(lv##S[i]); V_[(2 * i + 1) * 2] = bfhi(lv##S[i]); } } \
                if (q == 0 && c8 == 0) RK[(tok0 + (size_t)(chunk) * TC + tt) * 16 + h] = rk; } while (0)
#define SC_FLUSH(chunk) do { const LAS float* Yp_ = (const LAS float*)(lds + ((chunk) & 1) * SC_BUF) + 5 * TC * 64 + TC * 16; const int pp = p >> 4, row = p & 15; \
                  \
                const LAS f32x4* q4 = (const LAS f32x4*)(Yp_ + pp * 512 + row * 32); float ye_ = 0.f, yo_ = 0.f; \
                _Pragma("unroll") for (int o_ = 0; o_ < 8; ++o_) { const f32x4 t = q4[o_]; ye_ += t.x + t.z; yo_ += t.y + t.w; } \
                const float yep = dpp_mov<0xB1>(ye_), yop = dpp_mov<0xB1>(yo_);     \
                const size_t tk_ = tok0 + (size_t)(chunk) * TC + 2 * pp; \
                if ((row & 1) == 0) *(unsigned*)(Y + tk_ * D + h * 64 + 16 * q + row) = pk2(ye_, yep); \
                else *(unsigned*)(Y + (tk_ + 1) * D + h * 64 + 16 * q + row - 1) = pk2(yop, yo_); } while (0)
            SC_LOAD(0, 0); SC_PREP(0, 0, 0); SC_LOAD(1, 1);
            SC_BAR();
            for (int cidx = 0; cidx < SEQ / TC; cidx += 2) {
                if (cidx >= 1) SC_FLUSH(cidx - 1);
                SC_PREP(1, cidx + 1, 1);
                if (cidx + 2 < SEQ / TC) SC_LOAD(0, cidx + 2);
                SC_BAR();
                SC_FLUSH(cidx);
                if (cidx + 2 < SEQ / TC) { SC_PREP(0, cidx + 2, 0); if (cidx + 3 < SEQ / TC) SC_LOAD(1, cidx + 3); }
                SC_BAR();
            }
            SC_FLUSH(SEQ / TC - 1);
#undef SC_FLUSH
#undef SC_LOAD
#undef SC_PREP
        } else {
            const int j = lane & 15, lr = 4 * wave + (lane >> 4);
            f32x2 S01 = (f32x2){0.f, 0.f}, S23 = (f32x2){0.f, 0.f};
            SC_BAR();
#define SC_LDP(X, k) do { \
                asm volatile("ds_read_b128 %0, %1 offset:%2" : "=v"(ae##X) : "v"(aB), "n"(24576 + (2 * (k)) * 256)); \
                asm volatile("ds_read_b128 %0, %1 offset:%2" : "=v"(ao##X) : "v"(aB), "n"(24576 + (2 * (k) + 1) * 256)); \
                asm volatile("ds_read_b64 %0, %1 offset:%2" : "=v"(mn##X) : "v"(aM), "n"((k) * 8)); \
                asm volatile("ds_read_b64 %0, %1 offset:%2" : "=v"(vv##X) : "v"(aV), "n"((k) * 128)); \
                asm volatile("ds_read_b128 %0, %1 offset:%2" : "=v"(we##X) : "v"(aB), "n"(8192 + (2 * (k)) * 256)); \
                asm volatile("ds_read_b128 %0, %1 offset:%2" : "=v"(ke##X) : "v"(aB), "n"(16384 + (2 * (k)) * 256)); \
                asm volatile("ds_read_b128 %0, %1 offset:%2" : "=v"(be##X) : "v"(aB), "n"(32768 + (2 * (k)) * 256)); \
                asm volatile("ds_read_b128 %0, %1 offset:%2" : "=v"(re##X) : "v"(aB), "n"((2 * (k)) * 256)); \
                asm volatile("ds_read_b128 %0, %1 offset:%2" : "=v"(wo##X) : "v"(aB), "n"(8192 + (2 * (k) + 1) * 256)); \
                asm volatile("ds_read_b128 %0, %1 offset:%2" : "=v"(ko##X) : "v"(aB), "n"(16384 + (2 * (k) + 1) * 256)); \
                asm volatile("ds_read_b128 %0, %1 offset:%2" : "=v"(bo##X) : "v"(aB), "n"(32768 + (2 * (k) + 1) * 256)); \
                asm volatile("ds_read_b128 %0, %1 offset:%2" : "=v"(ro##X) : "v"(aB), "n"((2 * (k) + 1) * 256)); } while (0)
#define SC_WAIT(X, N) asm volatile("s_waitcnt lgkmcnt(" #N ")" : "+v"(ae##X), "+v"(ao##X), "+v"(mn##X), "+v"(vv##X), "+v"(we##X), "+v"(ke##X), "+v"(be##X), "+v"(re##X), "+v"(wo##X), "+v"(ko##X), "+v"(bo##X), "+v"(ro##X))
#define SC_PAIR(X, k) do { \
                const float ve_ = vv##X.x, vo_ = vv##X.y; \
                const f32x2 pe = S01 * (f32x2){ae##X.x, ae##X.y} + S23 * (f32x2){ae##X.z, ae##X.w}; \
                const f32x2 po = S01 * (f32x2){ao##X.x, ao##X.y} + S23 * (f32x2){ao##X.z, ao##X.w}; \
                const float ue = red16(pe.x + pe.y), rawo = red16(po.x + po.y); \
                S01 = S01 * (f32x2){we##X.x, we##X.y} + (f32x2){ke##X.x, ke##X.y} * ve_; S23 = S23 * (f32x2){we##X.z, we##X.w} + (f32x2){ke##X.z, ke##X.w} * ve_; \
                S01 = S01 + (f32x2){be##X.x, be##X.y} * ue; S23 = S23 + (f32x2){be##X.z, be##X.w} * ue; \
                f32x2 yy; { const f32x2 py = S01 * (f32x2){re##X.x, re##X.y} + S23 * (f32x2){re##X.z, re##X.w}; yy.x = py.x + py.y; } \
                const float uo = rawo + mn##X.x * ue + mn##X.y * ve_; \
                S01 = S01 * (f32x2){wo##X.x, wo##X.y} + (f32x2){ko##X.x, ko##X.y} * vo_; S23 = S23 * (f32x2){wo##X.z, wo##X.w} + (f32x2){ko##X.z, ko##X.w} * vo_; \
                S01 = S01 + (f32x2){bo##X.x, bo##X.y} * uo; S23 = S23 + (f32x2){bo##X.z, bo##X.w} * uo; \
                { const f32x2 py = S01 * (f32x2){ro##X.x, ro##X.y} + S23 * (f32x2){ro##X.z, ro##X.w}; yy.y = py.x + py.y; } \
                asm volatile("ds_write_b64 %0, %1 offset:%2" :: "v"(aY), "v"(yy), "n"((k) * 2048)); } while (0)
            static_assert(TC == 32, "scan step loop is written for 32-step chunks");
            for (int cidx = 0; cidx < SEQ / TC; ++cidx) {
                unsigned aB = (unsigned)(cidx & 1) * SC_BUF + 16u * j;
                unsigned aV = (unsigned)(cidx & 1) * SC_BUF + 5 * TC * 64 * 4 + 8u * lr;
                unsigned aY = (unsigned)(cidx & 1) * SC_BUF + 5 * TC * 64 * 4 + TC * 16 * 4 + 8u * tid;
                unsigned aM = (unsigned)(cidx & 1) * SC_BUF + 5 * TC * 64 * 4 + TC * 16 * 4 + TC * 256 * 4;
                f32x4 aeA, aoA, weA, keA, beA, reA, woA, koA, boA, roA, aeB, aoB, weB, keB, beB, reB, woB, koB, boB, roB; f32x2 mnA, mnB, vvA, vvB;
                SC_LDP(A, 0);
                SC_WAIT(A, 0); SC_LDP(B, 1); SC_PAIR(A, 0); SC_WAIT(B, 1); SC_LDP(A, 2); SC_PAIR(B, 1);
#define SC_IT(k0) SC_WAIT(A, 1); SC_LDP(B, (k0) + 1); SC_PAIR(A, (k0)); SC_WAIT(B, 1); SC_LDP(A, (k0) + 2); SC_PAIR(B, (k0) + 1);
                SC_IT(2) SC_IT(4) SC_IT(6) SC_IT(8) SC_IT(10) SC_IT(12)
#undef SC_IT
                SC_WAIT(A, 1); SC_LDP(B, 15); SC_PAIR(A, 14); SC_WAIT(B, 1); SC_PAIR(B, 15);
                asm volatile("s_waitcnt lgkmcnt(0)" ::: "memory");
                SC_BAR();
            }
#undef SC_LDP
#undef SC_PAIR
#undef SC_WAIT
        }
        __syncthreads();
    }
}

__device__ __forceinline__ void gn_phase(const bf16_t* Y, const bf16_t* RKV, const bf16_t* WAG, const float* RK, const float* gn_w, const float* gn_b, bf16_t* OUTA, int gw, int NGW, int lane) {
    const int hh = lane >> 3, c8 = lane & 7;
    for (int it = gw; it < T * 2; it += NGW) {
        const size_t tok = it >> 1; const int half = it & 1, h = half * 8 + hh, ch = h * 64 + 8 * c8;
        const u32x4 ly = *(const u32x4*)(Y + tok * D + ch), lv = *(const u32x4*)(RKV + tok * 3072 + 2048 + ch), lg = *(const u32x4*)(WAG + tok * 3072 + 2048 + ch);
        float y[8], v[8], g[8];
#pragma unroll
        for (int i = 0; i < 4; ++i) { y[2*i] = bflo(ly[i]); y[2*i+1] = bfhi(ly[i]); v[2*i] = bflo(lv[i]); v[2*i+1] = bfhi(lv[i]); g[2*i] = bflo(lg[i]); g[2*i+1] = bfhi(lg[i]); }
        float s = 0.f;
#pragma unroll
        for (int i = 0; i < 8; ++i) s += y[i];
        const float mu = red8(s) * (1.f / 64.f); float s2 = 0.f;
#pragma unroll
        for (int i = 0; i < 8; ++i) { y[i] -= mu; s2 += y[i] * y[i]; }
        const float rstd = __builtin_amdgcn_rsqf(red8(s2) * (1.f / 64.f) + GN_EPS), rk = RK[tok * 16 + h];
        const f32x4 w0 = *(const f32x4*)(gn_w + ch), w1 = *(const f32x4*)(gn_w + ch + 4), b0 = *(const f32x4*)(gn_b + ch), b1 = *(const f32x4*)(gn_b + ch + 4);
        float o[8];
#pragma unroll
        for (int i = 0; i < 8; ++i) { const float gw_ = i < 4 ? w0[i] : w1[i - 4], gb_ = i < 4 ? b0[i] : b1[i - 4]; o[i] = (y[i] * rstd * gw_ + gb_ + rk * v[i]) * g[i]; }
        u32x4 w; w.x = pk2(o[0], o[1]); w.y = pk2(o[2], o[3]); w.z = pk2(o[4], o[5]); w.w = pk2(o[6], o[7]);
        *(u32x4*)(OUTA + tok * D + ch) = w;
    }
}

__device__ __forceinline__ float softcap15(float x) { return 15.f * tanhf(x * (1.f / 15.f)); }
__device__ __forceinline__ float logsig(float x) { return fminf(x, 0.f) - log1pf(expf(-fabsf(x))); }
__device__ __forceinline__ float scan_add(float v, int lane) {
#pragma unroll
    for (int o = 1; o < 64; o <<= 1) { const float t = __shfl_up(v, o); if (lane >= o) v += t; }
    return v;
}
__device__ __forceinline__ float scan_max(float v, int lane) {
#pragma unroll
    for (int o = 1; o < 64; o <<= 1) { const float t = __shfl_up(v, o); if (lane >= o) v = fmaxf(v, t); }
    return v;
}
__device__ __forceinline__ float wave_max(float v) {
#pragma unroll
    for (int o = 1; o < 64; o <<= 1) v = fmaxf(v, __shfl_xor(v, o));
    return v;
}
__device__ __forceinline__ void conv8_raw(const u32x4 (&tap)[4], int ch, const LAS float* cwl, const LAS float* cbl, float (&o)[8]) {
    const f32x4 b0 = *(const LAS f32x4*)(cbl + ch), b1 = *(const LAS f32x4*)(cbl + ch + 4);
#pragma unroll
    for (int i = 0; i < 8; ++i) o[i] = i < 4 ? b0[i] : b1[i - 4];
#pragma unroll
    for (int jt = 0; jt < 4; ++jt) {
        const u32x4 l = tap[jt];
        const f32x4 w0 = *(const LAS f32x4*)(cwl + jt * 1024 + ch), w1 = *(const LAS f32x4*)(cwl + jt * 1024 + ch + 4);
        o[0] += w0.x * bflo(l.x); o[1] += w0.y * bfhi(l.x); o[2] += w0.z * bflo(l.y); o[3] += w0.w * bfhi(l.y);
        o[4] += w1.x * bflo(l.z); o[5] += w1.y * bfhi(l.z); o[6] += w1.z * bflo(l.w); o[7] += w1.w * bfhi(l.w);
    }
#pragma unroll
    for (int i = 0; i < 8; ++i) o[i] = siluf_(o[i]);
}
#define ML_TAPS(dst, tokbase, sposbase, chan) do { _Pragma("unroll") for (int jt_ = 0; jt_ < 4; ++jt_) \
    dst[jt_] = ((sposbase) - 3 + jt_ >= 0) ? *(const u32x4*)(P + ((tokbase) - 3 + jt_) * 3072 + (chan)) : (u32x4){0u, 0u, 0u, 0u}; } while (0)
constexpr int LS = 144;
constexpr int ML_CW_OFF = 102400;
__device__ __forceinline__ void ml_local_phase(const bf16_t* P, const float* GATES, const float* cw, const float* cb, const float* b_i, const float* b_f,
                                               float* CLOC, float* NLOC, float* MLOC, float* GTOT, LAS unsigned char* lds, int vcu, int G, int tid, int wave, int lane) {
    LAS unsigned char* Kt = lds; LAS unsigned char* VWt = lds + 64 * LS; LAS float* wls = (LAS float*)(lds + 192 * LS);
    LAS float* cwl = (LAS float*)(lds + ML_CW_OFF); LAS float* cbl = cwl + 4096;
    for (int i = tid; i < 4096; i += NTHR) cwl[i] = cw[i];
    for (int i = tid; i < 1024; i += NTHR) cbl[i] = cb[i];
    const int fr = lane & 15, fq = lane >> 4;
    u32x4 rk[4], rv[2]; float rgi = 0.f, rgf = 0.f;
#define ML12_LOAD(uu) do { const int c_ = (uu) & 63, h_ = ((uu) >> 6) & 7, b_ = (uu) >> 9; const size_t t0_ = (size_t)b_ * SEQ + (size_t)c_ * 64; \
        { const int s_ = tid >> 3, c8_ = tid & 7; ML_TAPS(rk, t0_ + s_, c_ * 64 + s_, 512 + h_ * 64 + 8 * c8_); } \
        _Pragma("unroll") for (int i_ = 0; i_ < 2; ++i_) rv[i_] = *(const u32x4*)(P + (t0_ + lane) * 3072 + 1024 + h_ * 128 + 8 * (wave + 8 * i_)); \
        if (wave == 0) { rgi = GATES[(t0_ + lane) * 16 + h_]; rgf = GATES[(t0_ + lane) * 16 + 8 + h_]; } } while (0)
    if (vcu < 2048) ML12_LOAD(vcu);
    __syncthreads();
    for (int u = vcu; u < 2048; u += G) {
        const int h = (u >> 6) & 7;
        if (wave == 0) {
            const float li = softcap15(rgi + b_i[h]), lf = logsig(softcap15(rgf + b_f[h]));
            const float bc = scan_add(lf, lane), gt = __shfl(bc, 63), loc = gt - bc + li, ml = wave_max(loc);
            wls[lane] = expf(loc - ml);
            if (lane == 0) { MLOC[u] = ml; GTOT[u] = gt; }
        }
        { const int s = tid >> 3, c8 = tid & 7; float kv[8];
          conv8_raw(rk, 512 + h * 64 + 8 * c8, cwl, cbl, kv);
#pragma unroll
          for (int i = 0; i < 8; ++i) *(LAS bf16_t*)(Kt + (8 * c8 + i) * LS + 2 * s) = (bf16_t)f2bf(kv[i]); }
        __syncthreads();
#pragma unroll
        for (int i = 0; i < 2; ++i) { const int s = lane, e8 = wave + 8 * i; const float wl = wls[s]; const u32x4 l = rv[i];
#pragma unroll
            for (int k = 0; k < 4; ++k) { *(LAS bf16_t*)(VWt + (8 * e8 + 2 * k) * LS + 2 * s) = (bf16_t)f2bf(bflo(l[k]) * wl); *(LAS bf16_t*)(VWt + (8 * e8 + 2 * k + 1) * LS + 2 * s) = (bf16_t)f2bf(bfhi(l[k]) * wl); } }
        if (u + G < 2048) ML12_LOAD(u + G);
        __syncthreads();
        { f32x4 acc[4];
#pragma unroll
          for (int n = 0; n < 4; ++n) acc[n] = (f32x4){0.f, 0.f, 0.f, 0.f};
#pragma unroll
          for (int ks = 0; ks < 2; ++ks) { const bf16x8 af = *(const LAS bf16x8*)(VWt + (16 * wave + fr) * LS + (ks * 32 + 8 * fq) * 2);
#pragma unroll
              for (int n = 0; n < 4; ++n) { const bf16x8 bfr = *(const LAS bf16x8*)(Kt + (16 * n + fr) * LS + (ks * 32 + 8 * fq) * 2);
                  acc[n] = __builtin_amdgcn_mfma_f32_16x16x32_bf16(bfr, af, acc[n], 0, 0, 0); } }
#pragma unroll
          for (int n = 0; n < 4; ++n) *(f32x4*)(CLOC + (size_t)u * 8192 + (16 * wave + fr) * 64 + 16 * n + 4 * fq) = acc[n]; }
        if (tid < 64) { float s_ = 0.f;
            for (int s = 0; s < 64; ++s) s_ += wls[s] * bf2f(*(const LAS bf16_t*)(Kt + tid * LS + 2 * s));
            NLOC[(size_t)u * 64 + tid] = s_; }
        __syncthreads();
    }
#undef ML12_LOAD
}
__device__ __forceinline__ void ml_scan_phase(const float* __restrict__ CLOC, const float* __restrict__ NLOC, const float* __restrict__ MLOC, const float* __restrict__ GTOT,
                                              bf16_t* __restrict__ CPT, float* __restrict__ NPREV, float* __restrict__ MPREV, int vcu, int G, int tid) {
    for (int it = vcu; it < 256; it += G) {
        const int bh = it >> 3, part = it & 7;
        if (tid >= 256) continue;
        const int idx = part * 1024 + 4 * tid;
        f32x4 C = (f32x4){0.f, 0.f, 0.f, 0.f}; float m = 0.f, nn = 0.f;
        const bool do_n = (part == 0 && tid < 64);
        for (int c0 = 0; c0 < 64; c0 += 16) {
            f32x4 cl[16]; float gc[16], ml[16], nl[16];
#pragma unroll
            for (int i = 0; i < 16; ++i) { const int u = bh * 64 + c0 + i; cl[i] = *(const f32x4*)(CLOC + (size_t)u * 8192 + idx); gc[i] = GTOT[u]; ml[i] = MLOC[u]; nl[i] = do_n ? NLOC[(size_t)u * 64 + tid] : 0.f; }
#pragma unroll
            for (int i = 0; i < 16; ++i) { const int u = bh * 64 + c0 + i;
                u32x2 o; o.x = pk2(C.x, C.y); o.y = pk2(C.z, C.w);
                *(u32x2*)(CPT + (size_t)u * 8192 + idx) = o;
                const float mn = fmaxf(gc[i] + m, ml[i]), sa = expf(gc[i] + m - mn), sb = expf(ml[i] - mn);
                if (do_n) { NPREV[(size_t)u * 64 + tid] = nn; nn = sa * nn + sb * nl[i]; if (tid == 0) MPREV[u] = m; }
                C = C * sa + cl[i] * sb; m = mn; }
        }
    }
}
__device__ __forceinline__ void ml_out_phase(const bf16_t* P, const float* GATES, const float* cw, const float* cb, const float* b_i, const float* b_f, const float* hn_w,
                                             const bf16_t* CPT, const float* NPREV, const float* MPREV, bf16_t* OUTA, LAS unsigned char* lds, int vcu, int G, int tid, int wave, int lane) {
    LAS unsigned char* Qs = lds; LAS unsigned char* Ks = lds + 64 * LS; LAS unsigned char* Vt = lds + 128 * LS; LAS unsigned char* CP = lds + 256 * LS; LAS unsigned char* Wi = lds + 384 * LS;
    LAS float* Ho = (LAS float*)(lds + 448 * LS);
    LAS float* sc_ = (LAS float*)(lds + 448 * LS + 64 * 132 * 4);
    static_assert(448 * LS + 64 * 132 * 4 + 1280 <= ML_CW_OFF, "mLSTM LDS map");
    LAS float* cwl = (LAS float*)(lds + ML_CW_OFF); LAS float* cbl = cwl + 4096;
    for (int i = tid; i < 4096; i += NTHR) cwl[i] = cw[i];
    for (int i = tid; i < 1024; i += NTHR) cbl[i] = cb[i];
    const int fr = lane & 15, fq = lane >> 4;
    u32x4 rq[4], rk[4], rv[2], rc[2], ro[2]; float rgi = 0.f, rgf = 0.f, rmp = 0.f, rnp = 0.f;
#define ML14_LOAD(uu) do { const int c_ = (uu) & 63, h_ = ((uu) >> 6) & 7, b_ = (uu) >> 9; const size_t t0_ = (size_t)b_ * SEQ + (size_t)c_ * 64; \
        { const int s_ = tid >> 3, c8_ = tid & 7; ML_TAPS(rq, t0_ + s_, c_ * 64 + s_, h_ * 64 + 8 * c8_); ML_TAPS(rk, t0_ + s_, c_ * 64 + s_, 512 + h_ * 64 + 8 * c8_); } \
        _Pragma("unroll") for (int i_ = 0; i_ < 2; ++i_) { rv[i_] = *(const u32x4*)(P + (t0_ + lane) * 3072 + 1024 + h_ * 128 + 8 * (wave + 8 * i_)); \
            const int it_ = tid + NTHR * i_; rc[i_] = *(const u32x4*)(CPT + (size_t)(uu) * 8192 + (it_ >> 3) * 64 + 8 * (it_ & 7)); } \
        if (wave == 0) { rgi = GATES[(t0_ + lane) * 16 + h_]; rgf = GATES[(t0_ + lane) * 16 + 8 + h_]; rmp = MPREV[(uu)]; rnp = NPREV[(size_t)(uu) * 64 + lane]; } } while (0)
#define ML14_LOAD_O(uu) do { const int c_ = (uu) & 63, h_ = ((uu) >> 6) & 7, b_ = (uu) >> 9; const size_t tok_ = (size_t)b_ * SEQ + (size_t)c_ * 64 + (tid >> 3); \
        ro[0] = *(const u32x4*)(P + tok_ * 3072 + 2048 + h_ * 128 + 16 * (tid & 7)); ro[1] = *(const u32x4*)(P + tok_ * 3072 + 2048 + h_ * 128 + 16 * (tid & 7) + 8); } while (0)
    if (vcu < 2048) { ML14_LOAD(vcu); ML14_LOAD_O(vcu); }
    __syncthreads();
    for (int u = vcu; u < 2048; u += G) {
        const int c = u & 63, h = (u >> 6) & 7, b = u >> 9;
        const size_t t0 = (size_t)b * SEQ + (size_t)c * 64;
        if (wave == 0) {
            const float li = softcap15(rgi + b_i[h]), lf = logsig(softcap15(rgf + b_f[h]));
            const float bc = scan_add(lf, lane), cm = scan_max(li - bc, lane);
            const float inter = bc + rmp, mt = fmaxf(inter, bc + cm);
            sc_[lane] = bc; sc_[64 + lane] = li; sc_[128 + lane] = mt; sc_[192 + lane] = expf(inter - mt); sc_[256 + lane] = rnp;
        }
        { const int s = tid >> 3, c8 = tid & 7; float v[8];
          conv8_raw(rq, h * 64 + 8 * c8, cwl, cbl, v);
          u32x4 w; w.x = pk2(v[0] * 0.125f, v[1] * 0.125f); w.y = pk2(v[2] * 0.125f, v[3] * 0.125f); w.z = pk2(v[4] * 0.125f, v[5] * 0.125f); w.w = pk2(v[6] * 0.125f, v[7] * 0.125f);
          *(LAS u32x4*)(Qs + s * LS + 16 * c8) = w;
          conv8_raw(rk, 512 + h * 64 + 8 * c8, cwl, cbl, v);
          w.x = pk2(v[0], v[1]); w.y = pk2(v[2], v[3]); w.z = pk2(v[4], v[5]); w.w = pk2(v[6], v[7]);
          *(LAS u32x4*)(Ks + s * LS + 16 * c8) = w; }
#pragma unroll
        for (int i = 0; i < 2; ++i) { const int s = lane, e8 = wave + 8 * i; const u32x4 l = rv[i];
#pragma unroll
            for (int k = 0; k < 4; ++k) { *(LAS bf16_t*)(Vt + (8 * e8 + 2 * k) * LS + 2 * s) = (bf16_t)(l[k] & 0xffffu); *(LAS bf16_t*)(Vt + (8 * e8 + 2 * k + 1) * LS + 2 * s) = (bf16_t)(l[k] >> 16); } }
#pragma unroll
        for (int i = 0; i < 2; ++i) { const int it = tid + NTHR * i, e = it >> 3, cc = it & 7; *(LAS u32x4*)(CP + e * LS + 16 * cc) = rc[i]; }
        if (u + G < 2048) ML14_LOAD(u + G);
        __syncthreads();
        const int mt_ = wave >> 1, nh = wave & 1;
        bf16x8 qf[2];
#pragma unroll
        for (int ks = 0; ks < 2; ++ks) qf[ks] = *(const LAS bf16x8*)(Qs + (16 * mt_ + fr) * LS + (ks * 32 + 8 * fq) * 2);
        {
            const int t = 16 * mt_ + fr; const float bct = sc_[t], mtt = sc_[128 + t];
#pragma unroll
            for (int n = 0; n < 2; ++n) { f32x4 acc = (f32x4){0.f, 0.f, 0.f, 0.f}; const int s0 = 16 * (2 * nh + n);
#pragma unroll
                for (int ks = 0; ks < 2; ++ks) { const bf16x8 kf = *(const LAS bf16x8*)(Ks + (s0 + fr) * LS + (ks * 32 + 8 * fq) * 2); acc = __builtin_amdgcn_mfma_f32_16x16x32_bf16(kf, qf[ks], acc, 0, 0, 0); }
                float wv[4];
#pragma unroll
                for (int j = 0; j < 4; ++j) { const int s = s0 + 4 * fq + j; wv[j] = (s <= t) ? __expf(bct - sc_[s] + sc_[64 + s] - mtt) * acc[j] : 0.f; }
                u32x2 w; w.x = pk2(wv[0], wv[1]); w.y = pk2(wv[2], wv[3]);
                *(LAS u32x2*)(Wi + t * LS + (s0 + 4 * fq) * 2) = w; }
        }
        __syncthreads();
        {
            const int t = 16 * mt_ + fr; const float wint = sc_[192 + t];
            bf16x8 wf[2];
#pragma unroll
            for (int ks = 0; ks < 2; ++ks) wf[ks] = *(const LAS bf16x8*)(Wi + (16 * mt_ + fr) * LS + (ks * 32 + 8 * fq) * 2);
#pragma unroll
            for (int n = 0; n < 4; ++n) { const int e0 = 16 * (4 * nh + n); f32x4 a1 = (f32x4){0.f, 0.f, 0.f, 0.f}, a2 = (f32x4){0.f, 0.f, 0.f, 0.f};
#pragma unroll
                for (int ks = 0; ks < 2; ++ks) { const bf16x8 cf = *(const LAS bf16x8*)(CP + (e0 + fr) * LS + (ks * 32 + 8 * fq) * 2), vf = *(const LAS bf16x8*)(Vt + (e0 + fr) * LS + (ks * 32 + 8 * fq) * 2);
                    a1 = __builtin_amdgcn_mfma_f32_16x16x32_bf16(cf, qf[ks], a1, 0, 0, 0); a2 = __builtin_amdgcn_mfma_f32_16x16x32_bf16(vf, wf[ks], a2, 0, 0, 0); }
                *(LAS f32x4*)(Ho + t * 132 + e0 + 4 * fq) = a1 * wint + a2; }
        }
        __syncthreads();
        { const int t = tid >> 3, p = tid & 7; float d1 = 0.f, d2 = 0.f;
#pragma unroll
          for (int i = 0; i < 8; ++i) { d1 += bf2f(*(const LAS bf16_t*)(Wi + t * LS + 2 * (8 * p + i))); d2 += bf2f(*(const LAS bf16_t*)(Qs + t * LS + 2 * (8 * p + i))) * sc_[256 + 8 * p + i]; }
          float den = red8(d1 + sc_[192 + t] * d2);
          den = fmaxf(fabsf(den), expf(-sc_[128 + t]));
          const float rden = __builtin_amdgcn_rcpf(den); float hv[16], ss = 0.f;
#pragma unroll
          for (int i = 0; i < 4; ++i) { const f32x4 x4 = *(const LAS f32x4*)(Ho + t * 132 + 16 * p + 4 * i);
#pragma unroll
              for (int k = 0; k < 4; ++k) { hv[4 * i + k] = x4[k] * rden; ss += hv[4 * i + k] * hv[4 * i + k]; } }
          const float scl = __builtin_amdgcn_rsqf(red8(ss) * (1.f / 128.f) + EPS);
          const size_t tok = t0 + t; const int ch = h * 128 + 16 * p;
          const u32x4 o0 = ro[0], o1 = ro[1];
          u32x4 w0, w1;
#pragma unroll
          for (int i = 0; i < 4; ++i) { const f32x4 hw = *(const f32x4*)(hn_w + ch + 4 * i);
              const unsigned ow0 = i < 2 ? o0[2 * i] : o1[2 * i - 4], ow1 = i < 2 ? o0[2 * i + 1] : o1[2 * i - 3];
              const unsigned r0 = pk2(hv[4 * i] * scl * hw.x * bflo(ow0), hv[4 * i + 1] * scl * hw.y * bfhi(ow0)), r1 = pk2(hv[4 * i + 2] * scl * hw.z * bflo(ow1), hv[4 * i + 3] * scl * hw.w * bfhi(ow1));
              if (i < 2) { w0[2 * i] = r0; w0[2 * i + 1] = r1; } else { w1[2 * i - 4] = r0; w1[2 * i - 3] = r1; } }
          *(u32x4*)(OUTA + tok * D + ch) = w0; *(u32x4*)(OUTA + tok * D + ch + 8) = w1; }
        if (u + G < 2048) ML14_LOAD_O(u + G);
        __syncthreads();
    }
#undef ML14_LOAD
#undef ML14_LOAD_O
}

__global__ void __launch_bounds__(NTHR, 2) trunk_fwd(Args args) {
    extern __shared__ __attribute__((aligned(16))) unsigned char lds_raw[];
    LAS unsigned char* lds = (LAS unsigned char*)lds_raw;
    const int G = gridDim.x, bx = blockIdx.x, vcu = (G % 8 == 0) ? (bx % 8) * (G / 8) + bx / 8 : bx;
    const int NGW = G * NWAVES;
    volatile LAS unsigned* MISC = (volatile LAS unsigned*)(lds + MISC_OFF);
    if (threadIdx.x < 32) MISC[threadIdx.x] = 0u;
    __syncthreads();
    XcdBarrier bar = xcd_barrier_post((unsigned*)(args.ws + WS_CTL), MISC + 8);
#define GRID_BAR() do { xcd_barrier(bar); if (DUP_BAR) xcd_barrier(bar); } while (0)
#define PHASE_BEGIN() int tid = threadIdx.x; asm volatile("" : "+v"(tid)); const int lane = tid & 63, wave = __builtin_amdgcn_readfirstlane(tid >> 6), gw = vcu * NWAVES + wave; (void)gw; (void)lane; \
    GAS unsigned char* ws_g = (GAS unsigned char*)args.ws; asm volatile("" : "+s"(ws_g)); GAS unsigned char* outp_g = (GAS unsigned char*)args.out; asm volatile("" : "+s"(outp_g)); \
    unsigned char* ws = (unsigned char*)ws_g; unsigned char* outp = (unsigned char*)outp_g; \
    float* MOD = (float*)(ws + WS_MOD); const float* MOD1 = MOD + 4 * 6144; (void)MOD1; \
    bf16_t* R1 = (bf16_t*)(ws + WS_R1); bf16_t* R2 = (bf16_t*)(ws + WS_R2); float* XB = (float*)(ws + WS_R2); (void)R1; (void)R2; (void)XB; \
    bf16_t* DO_LO = (bf16_t*)outp; bf16_t* DO_HI = (bf16_t*)(outp + 32 * MiB); (void)DO_LO; (void)DO_HI; \
    LAS float* scr = (LAS float*)(lds + wave * TR_SCR); (void)scr;
    int rot = 0;

    { PHASE_BEGIN();
        ada_phase(args.in[1], args.in[2], args.in[3], MOD, lds, vcu, G, tid, wave, lane);
        bf16_t* Wrkv = (bf16_t*)(ws + WS_WRKV); bf16_t* Wl = (bf16_t*)(ws + WS_WL); bf16_t* Wup = (bf16_t*)(ws + WS_WUP); bf16_t* Wo0 = (bf16_t*)(ws + WS_WO0);
        bf16_t* Wgu0 = (bf16_t*)(ws + WS_WGU0); bf16_t* Wd0 = (bf16_t*)(ws + WS_WD0);
        const float* w_in = args.in[5]; const float* mix = args.in[4];
        tr_job(w_in, 3360, 0, 1024, 1024, 1024, Wrkv, 1024, 0, 0, nullptr, 0, scr, rot, gw, NGW, lane);
        tr_job(w_in, 3360, 1088, 1024, 1024, 1024, Wrkv, 1024, 1024, 0, nullptr, 0, scr, rot, gw, NGW, lane);
        tr_job(w_in, 3360, 2112, 1024, 1024, 1024, Wrkv, 1024, 2048, 0, nullptr, 0, scr, rot, gw, NGW, lane);
        tr_job(w_in, 3360, 1024, 64, 1024, 1024, Wl, 2048, 0, 0, nullptr, 0, scr, rot, gw, NGW, lane);
        tr_job(w_in, 3360, 1024, 64, 1024, 1024, Wl, 2048, 0, 1024, mix + 1 * D, 0, scr, rot, gw, NGW, lane);
        tr_job(w_in, 3360, 3136, 64, 1024, 1024, Wl, 2048, 128, 0, nullptr, 0, scr, rot, gw, NGW, lane);
        tr_job(w_in, 3360, 3136, 64, 1024, 1024, Wl, 2048, 128, 1024, mix + 4 * D, 0, scr, rot, gw, NGW, lane);
        tr_job(w_in, 3360, 3200, 160, 1024, 1024, Wl, 2048, 256, 0, nullptr, 0, scr, rot, gw, NGW, lane);
        tr_job(w_in, 3360, 3200, 160, 1024, 1024, Wl, 2048, 256, 1024, mix + 5 * D, 0, scr, rot, gw, NGW, lane);
        for (int i = gw * 64 + lane; i < (64 + 64 + 96) * 256; i += NGW * 64) { const int r = i >> 8, c16 = i & 255; const int row = r < 64 ? 64 + r : (r < 128 ? 192 + (r - 64) : 416 + (r - 128));
            *(u32x4*)(Wl + (size_t)row * 2048 + 8 * c16) = (u32x4){0u, 0u, 0u, 0u}; }
        tr_job(args.in[7], 1024, 0, 1024, 256, 64, Wup, 256, 0, 0, nullptr, 0, scr, rot, gw, NGW, lane);
        tr_job(args.in[9], 1024, 0, 1024, 256, 64, Wup, 256, 1024, 0, nullptr, 0, scr, rot, gw, NGW, lane);
        tr_job(args.in[10], 1024, 0, 1024, 256, 160, Wup, 256, 2048, 0, nullptr, 0, scr, rot, gw, NGW, lane);
        tr_job(args.in[16], 1024, 0, 1024, 1024, 1024, Wo0, 1024, 0, 0, nullptr, 0, scr, rot, gw, NGW, lane);
        tr_job(args.in[24], 2 * FF, 0, 2 * FF, 1024, 1024, Wgu0, 1024, 0, 0, nullptr, 1, scr, rot, gw, NGW, lane);
        tr_job(args.in[25], 1024, 0, 1024, FF, FF, Wd0, FF, 0, 0, nullptr, 0, scr, rot, gw, NGW, lane);
    }
#if DUP_TR
    __syncthreads();
    { PHASE_BEGIN();
        ada_phase(args.in[1], args.in[2], args.in[3], MOD, lds, vcu, G, tid, wave, lane);
        bf16_t* Wrkv = (bf16_t*)(ws + WS_WRKV); bf16_t* Wl = (bf16_t*)(ws + WS_WL); bf16_t* Wup = (bf16_t*)(ws + WS_WUP); bf16_t* Wo0 = (bf16_t*)(ws + WS_WO0);
        bf16_t* Wgu0 = (bf16_t*)(ws + WS_WGU0); bf16_t* Wd0 = (bf16_t*)(ws + WS_WD0);
        const float* w_in = args.in[5]; const float* mix = args.in[4];
        tr_job(w_in, 3360, 0, 1024, 1024, 1024, Wrkv, 1024, 0, 0, nullptr, 0, scr, rot, gw, NGW, lane);
        tr_job(w_in, 3360, 1088, 1024, 1024, 1024, Wrkv, 1024, 1024, 0, nullptr, 0, scr, rot, gw, NGW, lane);
        tr_job(w_in, 3360, 2112, 1024, 1024, 1024, Wrkv, 1024, 2048, 0, nullptr, 0, scr, rot, gw, NGW, lane);
        tr_job(w_in, 3360, 1024, 64, 1024, 1024, Wl, 2048, 0, 0, nullptr, 0, scr, rot, gw, NGW, lane);
        tr_job(w_in, 3360, 1024, 64, 1024, 1024, Wl, 2048, 0, 1024, mix + 1 * D, 0, scr, rot, gw, NGW, lane);
        tr_job(w_in, 3360, 3136, 64, 1024, 1024, Wl, 2048, 128, 0, nullptr, 0, scr, rot, gw, NGW, lane);
        tr_job(w_in, 3360, 3136, 64, 1024, 1024, Wl, 2048, 128, 1024, mix + 4 * D, 0, scr, rot, gw, NGW, lane);
        tr_job(w_in, 3360, 3200, 160, 1024, 1024, Wl, 2048, 256, 0, nullptr, 0, scr, rot, gw, NGW, lane);
        tr_job(w_in, 3360, 3200, 160, 1024, 1024, Wl, 2048, 256, 1024, mix + 5 * D, 0, scr, rot, gw, NGW, lane);
        for (int i = gw * 64 + lane; i < (64 + 64 + 96) * 256; i += NGW * 64) { const int r = i >> 8, c16 = i & 255; const int row = r < 64 ? 64 + r : (r < 128 ? 192 + (r - 64) : 416 + (r - 128));
            *(u32x4*)(Wl + (size_t)row * 2048 + 8 * c16) = (u32x4){0u, 0u, 0u, 0u}; }
        tr_job(args.in[7], 1024, 0, 1024, 256, 64, Wup, 256, 0, 0, nullptr, 0, scr, rot, gw, NGW, lane);
        tr_job(args.in[9], 1024, 0, 1024, 256, 64, Wup, 256, 1024, 0, nullptr, 0, scr, rot, gw, NGW, lane);
        tr_job(args.in[10], 1024, 0, 1024, 256, 160, Wup, 256, 2048, 0, nullptr, 0, scr, rot, gw, NGW, lane);
        tr_job(args.in[16], 1024, 0, 1024, 1024, 1024, Wo0, 1024, 0, 0, nullptr, 0, scr, rot, gw, NGW, lane);
        tr_job(args.in[24], 2 * FF, 0, 2 * FF, 1024, 1024, Wgu0, 1024, 0, 0, nullptr, 1, scr, rot, gw, NGW, lane);
        tr_job(args.in[25], 1024, 0, 1024, FF, FF, Wd0, FF, 0, 0, nullptr, 0, scr, rot, gw, NGW, lane);
    }
#endif
    cg::this_grid().sync();
    __syncthreads();

    { PHASE_BEGIN(); p1_phase(args.in[0], MOD, args.in[4], R1, DO_LO, gw, NGW, lane); }
#if DUP_NORM
    { PHASE_BEGIN(); p1_phase(args.in[0], MOD, args.in[4], R1, DO_LO, gw, NGW, lane); }
#endif
    GRID_BAR();

    { PHASE_BEGIN();
        pg8::Gemm g2{DO_LO, (bf16_t*)(ws + WS_WL), 2048, 2048, 2048, 0}; pg8::StaticOrder S2; S2.init(T, 512, G, bx);
        pg8::EpiBf16 E2{(bf16_t*)(ws + WS_L), 512, 1};
        pg8::gemm_phase<pg8::EpiBf16, true>(lds, g2, S2, E2);
    }
    { PHASE_BEGIN();
        pg8::Gemm g{R1, (bf16_t*)(ws + WS_WRKV), 1024, 1024, 1024, (size_t)T * D * 2}; pg8::StaticOrder S;
        if (G == 256) { if (bx < 128) S.init_sub(T, 3072, 512, 128, bx, 2); else S.init_sub(T, 3072, 0, 128, bx - 128, 4); } else S.init(T, 3072, G, bx);
        pg8::EpiBf16 E{R2, 3072, 0};
        pg8::gemm_phase<pg8::EpiBf16, true>(lds, g, S, E);
    }
    GRID_BAR();

    { PHASE_BEGIN();
        pg8::Gemm g{(bf16_t*)(ws + WS_L), (bf16_t*)(ws + WS_WUP), 512, 256, 256, (size_t)128 * 2}; pg8::StaticOrder S; S.init(T, 3072, G, bx);
        pg8::EpiUp E{R1, args.in[6], args.in[8]};
        pg8::gemm_phase<pg8::EpiUp, true>(lds, g, S, E);
    }
    GRID_BAR();

    { PHASE_BEGIN(); scan_phase<0>(R2, R1, args.in[11], args.in[12], args.in[13], DO_LO, (float*)(ws + WS_RK), lds, vcu, G, tid, wave, lane); }
    GRID_BAR();
#if DUP_SCAN
    { PHASE_BEGIN(); scan_phase<DUP_SCAN - 1>(R2, R1, args.in[11], args.in[12], args.in[13], DO_HI, (float*)(ws + WS_GATES), lds, vcu, G, tid, wave, lane); }
    GRID_BAR();
#endif

    { PHASE_BEGIN();
        gn_phase(DO_LO, R2, R1, (const float*)(ws + WS_RK), args.in[14], args.in[15], DO_HI, gw, NGW, lane);
        tr_job(args.in[17], 3088, 0, 3072, 1024, 1024, (bf16_t*)(ws + WS_WML), 1024, 0, 0, nullptr, 0, scr, rot, gw, NGW, lane);
        tr_job(args.in[23], 1024, 0, 1024, 1024, 1024, (bf16_t*)(ws + WS_WO1), 1024, 0, 0, nullptr, 0, scr, rot, gw, NGW, lane);
        tr_job(args.in[24] + (size_t)D * 2 * FF, 2 * FF, 0, 2 * FF, 1024, 1024, (bf16_t*)(ws + WS_WGU1), 1024, 0, 0, nullptr, 1, scr, rot, gw, NGW, lane);
        tr_job(args.in[25] + (size_t)FF * D, 1024, 0, 1024, FF, FF, (bf16_t*)(ws + WS_WD1), FF, 0, 0, nullptr, 0, scr, rot, gw, NGW, lane);
    }
    GRID_BAR();

    { PHASE_BEGIN();
        pg8::Gemm g{DO_HI, (bf16_t*)(ws + WS_WO0), 1024, 1024, 1024, 0}; pg8::StaticOrder S; S.init(T, 1024, G, bx);
        pg8::EpiResid E{args.in[0], XB, MOD + 2048};
        pg8::gemm_phase<pg8::EpiResid, true>(lds, g, S, E);
    }
    GRID_BAR();

    { PHASE_BEGIN(); norm_phase(XB, MOD + 3072, MOD + 4096, DO_LO, gw, NGW, lane); }
#if DUP_NORM
    { PHASE_BEGIN(); norm_phase(XB, MOD + 3072, MOD + 4096, DO_LO, gw, NGW, lane); }
#endif
    GRID_BAR();
    { PHASE_BEGIN();
        pg8::Gemm g{DO_LO, (bf16_t*)(ws + WS_WGU0), 1024, 1024, 1024, 0}; pg8::StaticOrder S; S.init(T, 2 * FF, G, bx);
        pg8::EpiSwiglu E{R1};
        pg8::gemm_phase<pg8::EpiSwiglu, true>(lds, g, S, E);
    }
    GRID_BAR();
    { PHASE_BEGIN();
        pg8::Gemm g{R1, (bf16_t*)(ws + WS_WD0), FF, FF, FF, 0}; pg8::StaticOrder S; S.init(T, 1024, G, bx);
        pg8::EpiResid E{XB, XB, MOD + 5120};
        pg8::gemm_phase<pg8::EpiResid, true>(lds, g, S, E);
    }
    GRID_BAR();

    { PHASE_BEGIN(); norm_gates_phase(XB, MOD1, MOD1 + 1024, args.in[17], DO_LO, (float*)(ws + WS_GATES), lds, gw, NGW, tid, lane); }
#if DUP_NORM
    { PHASE_BEGIN(); norm_gates_phase(XB, MOD1, MOD1 + 1024, args.in[17], DO_LO, (float*)(ws + WS_GATES), lds, gw, NGW, tid, lane); }
#endif
    GRID_BAR();
    { PHASE_BEGIN();
        pg8::Gemm g{DO_LO, (bf16_t*)(ws + WS_WML), 1024, 1024, 1024, 0}; pg8::StaticOrder S; S.init(T, 3072, G, bx);
        pg8::EpiBf16 E{R1, 3072, 2};
        pg8::gemm_phase<pg8::EpiBf16, true>(lds, g, S, E);
    }
    GRID_BAR();
    { PHASE_BEGIN();
        ml_local_phase(R1, (const float*)(ws + WS_GATES), args.in[18], args.in[19], args.in[20], args.in[21], (float*)outp, (float*)(ws + WS_NLOC), (float*)(ws + WS_MLOC), (float*)(ws + WS_GTOT), lds, vcu, G, tid, wave, lane);
    }
    GRID_BAR();
    { PHASE_BEGIN();
        ml_scan_phase((const float*)outp, (const float*)(ws + WS_NLOC), (const float*)(ws + WS_MLOC), (const float*)(ws + WS_GTOT), (bf16_t*)(ws + WS_R2 + 64 * MiB), (float*)(ws + WS_NPREV), (float*)(ws + WS_MPREV), vcu, G, tid);
    }
    GRID_BAR();
    { PHASE_BEGIN();
        ml_out_phase(R1, (const float*)(ws + WS_GATES), args.in[18], args.in[19], args.in[20], args.in[21], args.in[22], (const bf16_t*)(ws + WS_R2 + 64 * MiB), (const float*)(ws + WS_NPREV), (const float*)(ws + WS_MPREV), DO_LO, lds, vcu, G, tid, wave, lane);
    }
    GRID_BAR();
#if DUP_ML
    { PHASE_BEGIN();
        ml_local_phase(R1, (const float*)(ws + WS_GATES), args.in[18], args.in[19], args.in[20], args.in[21], (float*)outp, (float*)(ws + WS_NLOC), (float*)(ws + WS_MLOC), (float*)(ws + WS_GTOT), lds, vcu, G, tid, wave, lane);
    }
    GRID_BAR();
    { PHASE_BEGIN();
        ml_scan_phase((const float*)outp, (const float*)(ws + WS_NLOC), (const float*)(ws + WS_MLOC), (const float*)(ws + WS_GTOT), (bf16_t*)(ws + WS_R2 + 64 * MiB), (float*)(ws + WS_NPREV), (float*)(ws + WS_MPREV), vcu, G, tid);
    }
    GRID_BAR();
    { PHASE_BEGIN();
        ml_out_phase(R1, (const float*)(ws + WS_GATES), args.in[18], args.in[19], args.in[20], args.in[21], args.in[22], (const bf16_t*)(ws + WS_R2 + 64 * MiB), (const float*)(ws + WS_NPREV), (const float*)(ws + WS_MPREV), DO_LO, lds, vcu, G, tid, wave, lane);
    }
    GRID_BAR();
#endif
    { PHASE_BEGIN();
        pg8::Gemm g{DO_LO, (bf16_t*)(ws + WS_WO1), 1024, 1024, 1024, 0}; pg8::StaticOrder S; S.init(T, 1024, G, bx);
        pg8::EpiResid E{XB, XB, MOD1 + 2048};
        pg8::gemm_phase<pg8::EpiResid, true>(lds, g, S, E);
    }
    GRID_BAR();
    { PHASE_BEGIN(); norm_phase(XB, MOD1 + 3072, MOD1 + 4096, DO_LO, gw, NGW, lane); }
#if DUP_NORM
    { PHASE_BEGIN(); norm_phase(XB, MOD1 + 3072, MOD1 + 4096, DO_LO, gw, NGW, lane); }
#endif
    GRID_BAR();
    { PHASE_BEGIN();
        pg8::Gemm g{DO_LO, (bf16_t*)(ws + WS_WGU1), 1024, 1024, 1024, 0}; pg8::StaticOrder S; S.init(T, 2 * FF, G, bx);
        pg8::EpiSwiglu E{R1};
        pg8::gemm_phase<pg8::EpiSwiglu, true>(lds, g, S, E);
    }
    GRID_BAR();
    { PHASE_BEGIN();
        pg8::Gemm g{R1, (bf16_t*)(ws + WS_WD1), FF, FF, FF, 0}; pg8::StaticOrder S; S.init(T, 1024, G, bx);
        pg8::EpiResid E{XB, XB, MOD1 + 5120};
        pg8::gemm_phase<pg8::EpiResid, true>(lds, g, S, E);
    }
    GRID_BAR();
    { PHASE_BEGIN(); final_norm_phase(XB, args.in[26], (float*)outp, gw, NGW, lane); }
#if DUP_NORM
    { PHASE_BEGIN(); final_norm_phase(XB, args.in[26], (float*)outp, gw, NGW, lane); }
#endif
}

extern "C" void kernel_launch(void* const* d_in, const int* in_sizes, int n_in, void* d_out, int out_size, void* d_ws, size_t ws_size, hipStream_t stream) {
    static int grid = 0;
    if (grid == 0) {
        if (n_in != 27 || out_size != T * D || ws_size < 256 * MiB) { fprintf(stderr, "kernel_launch: unexpected shapes (n_in %d out %d ws %zu)\n", n_in, out_size, ws_size); grid = -1; return; }
        int dev = 0, cus = 0, per_cu = 0;
        hipGetDevice(&dev); hipDeviceGetAttribute(&cus, hipDeviceAttributeMultiprocessorCount, dev);
        if (hipFuncSetAttribute((const void*)trunk_fwd, hipFuncAttributeMaxDynamicSharedMemorySize, LDS_BYTES) != hipSuccess) { fprintf(stderr, "kernel_launch: hipFuncSetAttribute failed\n"); grid = -1; return; }
        if (hipOccupancyMaxActiveBlocksPerMultiprocessor(&per_cu, (const void*)trunk_fwd, NTHR, LDS_BYTES) != hipSuccess || per_cu < 1) { fprintf(stderr, "kernel_launch: occupancy query says %d\n", per_cu); per_cu = 1; }
        (void)hipGetLastError();
        grid = cus * per_cu;
    }
    if (grid < 0) return;
    hipMemsetAsync((char*)d_ws + WS_CTL, 0, XCD_BAR_WORDS * 4, stream);
    Args a{};
    for (int i = 0; i < 27; ++i) a.in[i] = (const float*)d_in[i];
    a.out = (float*)d_out; a.ws = (unsigned char*)d_ws;
    void* kargs[] = {&a};
    hipError_t e = hipLaunchCooperativeKernel((const void*)trunk_fwd, dim3(grid), dim3(NTHR), kargs, LDS_BYTES, stream);
    if (e != hipSuccess) fprintf(stderr, "cooperative launch failed: %s (grid %d)\n", hipGetErrorString(e), grid);
}
```
